# Optimizing an MI355X kernel written in HIP

```python
import jax, jax.numpy as jnp
from jax import lax
import numpy as np

D_MODEL = 1024
BATCH = 4
SEQ = 4096
DEPTH = 4
DEC_BATCH = 8
DEC_SEQ = 32
PAST_LEN = 1024

CHUNK = 64
N_MIXERS = 2
N_SGU_LAYERS = (DEPTH + 1) // 2
N_CONV_LAYERS = DEPTH // 2
SGU_CHUNK = 128
SGU_HEADS = 4
D_SGU_FFN = 6 * D_MODEL
D_SGU = D_SGU_FFN // 2
SGU_HEAD_DIM = D_SGU // SGU_HEADS
CONV_WIDTH = 31
CONV_STATE = CONV_WIDTH - 1
D_FF = -(-8 * D_MODEL // (3 * 256)) * 256
RMS_EPS = 1e-6
LN_EPS = 1e-5

kernel_name = "streaming_gmlp_conformer_conv_hybrid"


def rms_norm(x, g):
    xf = x.astype(jnp.float32)
    y = xf * lax.rsqrt(jnp.mean(xf * xf, axis=-1, keepdims=True) + RMS_EPS)
    return (y * g.astype(jnp.float32)).astype(x.dtype)


def layer_norm(x, g, b):
    xf = x.astype(jnp.float32)
    mu = jnp.mean(xf, axis=-1, keepdims=True)
    xc = xf - mu
    var = jnp.mean(xc * xc, axis=-1, keepdims=True)
    y = xc * lax.rsqrt(var + LN_EPS)
    return (y * g.astype(jnp.float32) + b.astype(jnp.float32)).astype(x.dtype)


def sgu_mixer(h, w_in, b_in, ln_g, ln_b, w_s, b_s, w_out, b_out):
    B, T, _ = h.shape
    z = jax.nn.gelu(h @ w_in + b_in)
    u, v = z[..., :D_SGU], z[..., D_SGU:]
    v = layer_norm(v, ln_g, ln_b)
    L = min(T, SGU_CHUNK)
    C = T // L
    mask = jnp.tril(jnp.ones((SGU_CHUNK, SGU_CHUNK), dtype=w_s.dtype))
    ws = (w_s * mask)[:, :L, :L]
    vc = v.reshape(B, C, L, SGU_HEADS, SGU_HEAD_DIM)
    mixed = jnp.einsum('hij,bcjhd->bcihd', ws, vc) + b_s[:, :L].T[None, None, :, :, None]
    gated = u * mixed.reshape(B, T, D_SGU)
    y = gated @ w_out + b_out
    return y, v


def conv_mixer(h, past, w_pw1, b_pw1, w_dw, b_dw, ln_g, ln_b, w_pw2, b_pw2):
    a = h @ w_pw1 + b_pw1
    glu = a[..., :D_MODEL] * jax.nn.sigmoid(a[..., D_MODEL:])
    padded = jnp.concatenate([past, glu], axis=1)
    new_state = padded[:, -CONV_STATE:]
    c = lax.conv_general_dilated(
        padded, w_dw[:, None, :], window_strides=(1,), padding='VALID',
        dimension_numbers=('NWC', 'WIO', 'NWC'), feature_group_count=D_MODEL) + b_dw
    c = jax.nn.silu(layer_norm(c, ln_g, ln_b))
    y = c @ w_pw2 + b_pw2
    return y, new_state


def swiglu(h, w_gate, w_up, w_down):
    return (jax.nn.silu(h @ w_gate) * (h @ w_up)) @ w_down


def trunk(x, conv_past, norm_mix_g, norm_ffn_g, norm_final_g,
          sgu_w_in, sgu_b_in, sgu_ln_g, sgu_ln_b, sgu_w_s, sgu_b_s, sgu_w_out, sgu_b_out,
          conv_w_pw1, conv_b_pw1, conv_w_dw, conv_b_dw, conv_ln_g, conv_ln_b, conv_w_pw2, conv_b_pw2,
          ffn_w_gate, ffn_w_up, ffn_w_down):
    conv_states, sgu_vs = [], []
    for i in range(DEPTH):
        h = rms_norm(x, norm_mix_g[i])
        j = i // N_MIXERS
        if i % N_MIXERS == 0:
            y, v = sgu_mixer(h, sgu_w_in[j], sgu_b_in[j], sgu_ln_g[j], sgu_ln_b[j],
                             sgu_w_s[j], sgu_b_s[j], sgu_w_out[j], sgu_b_out[j])
            sgu_vs.append(v)
        else:
            y, st = conv_mixer(h, conv_past[j], conv_w_pw1[j], conv_b_pw1[j], conv_w_dw[j],
                               conv_b_dw[j], conv_ln_g[j], conv_ln_b[j], conv_w_pw2[j], conv_b_pw2[j])
            conv_states.append(st)
        x = x + y
        h = rms_norm(x, norm_ffn_g[i])
        x = x + swiglu(h, ffn_w_gate[i], ffn_w_up[i], ffn_w_down[i])
    return rms_norm(x, norm_final_g), jnp.stack(conv_states), jnp.stack(sgu_vs)


def setup_inputs(seed: int = 0) -> dict:
    key = jax.random.key(seed)
    ks = jax.random.split(key, 32)
    f32 = jnp.float32

    def nrm(k, shape, scale):
        return jax.random.normal(k, shape, f32) * scale

    def gain(k, shape):
        return 1.0 + 0.02 * jax.random.normal(k, shape, f32)

    return {
        "x_prompt": nrm(ks[0], (BATCH, SEQ, D_MODEL), 1.0),
        "x_sample": nrm(ks[1], (DEC_BATCH, DEC_SEQ, D_MODEL), 1.0),
        "state_conv": nrm(ks[2], (N_CONV_LAYERS, DEC_BATCH, CONV_STATE, D_MODEL), 0.5),
        "norm_mix_g": gain(ks[3], (DEPTH, D_MODEL)),
        "norm_ffn_g": gain(ks[4], (DEPTH, D_MODEL)),
        "norm_final_g": gain(ks[5], (D_MODEL,)),
        "sgu_w_in": nrm(ks[6], (N_SGU_LAYERS, D_MODEL, D_SGU_FFN), D_MODEL ** -0.5),
        "sgu_b_in": nrm(ks[7], (N_SGU_LAYERS, D_SGU_FFN), 0.02),
        "sgu_ln_g": gain(ks[8], (N_SGU_LAYERS, D_SGU)),
        "sgu_ln_b": nrm(ks[9], (N_SGU_LAYERS, D_SGU), 0.02),
        "sgu_w_s": nrm(ks[10], (N_SGU_LAYERS, SGU_HEADS, SGU_CHUNK, SGU_CHUNK), 0.5 * SGU_CHUNK ** -0.5),
        "sgu_b_s": gain(ks[11], (N_SGU_LAYERS, SGU_HEADS, SGU_CHUNK)),
        "sgu_w_out": nrm(ks[12], (N_SGU_LAYERS, D_SGU, D_MODEL), D_SGU ** -0.5),
        "sgu_b_out": nrm(ks[13], (N_SGU_LAYERS, D_MODEL), 0.02),
        "conv_w_pw1": nrm(ks[14], (N_CONV_LAYERS, D_MODEL, 2 * D_MODEL), D_MODEL ** -0.5),
        "conv_b_pw1": nrm(ks[15], (N_CONV_LAYERS, 2 * D_MODEL), 0.02),
        "conv_w_dw": nrm(ks[16], (N_CONV_LAYERS, CONV_WIDTH, D_MODEL), CONV_WIDTH ** -0.5),
        "conv_b_dw": nrm(ks[17], (N_CONV_LAYERS, D_MODEL), 0.02),
        "conv_ln_g": gain(ks[18], (N_CONV_LAYERS, D_MODEL)),
        "conv_ln_b": nrm(ks[19], (N_CONV_LAYERS, D_MODEL), 0.02),
        "conv_w_pw2": nrm(ks[20], (N_CONV_LAYERS, D_MODEL, D_MODEL), D_MODEL ** -0.5),
        "conv_b_pw2": nrm(ks[21], (N_CONV_LAYERS, D_MODEL), 0.02),
        "ffn_w_gate": nrm(ks[22], (DEPTH, D_MODEL, D_FF), D_MODEL ** -0.5),
        "ffn_w_up": nrm(ks[23], (DEPTH, D_MODEL, D_FF), D_MODEL ** -0.5),
        "ffn_w_down": nrm(ks[24], (DEPTH, D_FF, D_MODEL), D_FF ** -0.5),
    }


def reference(x_prompt, x_sample, state_conv, norm_mix_g, norm_ffn_g, norm_final_g,
              sgu_w_in, sgu_b_in, sgu_ln_g, sgu_ln_b, sgu_w_s, sgu_b_s, sgu_w_out, sgu_b_out,
              conv_w_pw1, conv_b_pw1, conv_w_dw, conv_b_dw, conv_ln_g, conv_ln_b, conv_w_pw2, conv_b_pw2,
              ffn_w_gate, ffn_w_up, ffn_w_down):
    weights = (norm_mix_g, norm_ffn_g, norm_final_g,
               sgu_w_in, sgu_b_in, sgu_ln_g, sgu_ln_b, sgu_w_s, sgu_b_s, sgu_w_out, sgu_b_out,
               conv_w_pw1, conv_b_pw1, conv_w_dw, conv_b_dw, conv_ln_g, conv_ln_b, conv_w_pw2, conv_b_pw2,
               ffn_w_gate, ffn_w_up, ffn_w_down)
    zero_past = jnp.zeros((N_CONV_LAYERS, x_prompt.shape[0], CONV_STATE, D_MODEL), dtype=x_prompt.dtype)
    y_prompt, new_conv_prompt, _ = trunk(x_prompt, zero_past, *weights)
    y_sample, new_conv_sample, new_sgu_v_sample = trunk(x_sample, state_conv, *weights)
    return (y_prompt, y_sample, new_conv_prompt, new_conv_sample, new_sgu_v_sample)
```

```cpp
#include <hip/hip_runtime.h>
#include <cstdio>
#include <cstdint>

#ifndef MK_N_LAUNCHES
#define MK_N_LAUNCHES 1
#endif

#ifndef PROBE_T
#define PROBE_T 0u
#endif
#ifndef PROBE_MASK
#define PROBE_MASK 0
#endif
#define LAS __attribute__((address_space(3)))
#define GAS __attribute__((address_space(1)))
typedef unsigned short bf16_t;
typedef short bf16x8 __attribute__((ext_vector_type(8)));
typedef float f32x4 __attribute__((ext_vector_type(4)));
typedef float f32x2 __attribute__((ext_vector_type(2)));
typedef unsigned u32x4 __attribute__((ext_vector_type(4)));
typedef unsigned u32x2 __attribute__((ext_vector_type(2)));

constexpr int D = 1024, MP = 16384, MS = 256, M = MP + MS, DSGU = 3072, DSF = 6144, DFF = 2816, NGU = 2 * DFF;
constexpr int NPHASE = 22;
constexpr float RMS_EPS = 1e-6f, LN_EPS = 1e-5f;

constexpr size_t O_Y = 0, O_CP = (size_t)M * D, O_CS = O_CP + 2 * 4 * 30 * 1024, O_SV = O_CS + 2 * 8 * 30 * 1024, O_END = O_SV + 2 * 8 * 32 * 3072;

constexpr size_t MiB = 1u << 20;
constexpr size_t WS_CTL = 0, CTL_ZERO_BYTES = 1 * MiB;
constexpr size_t WS_SSQA = 1 * MiB, WS_SSQB = WS_SSQA + 1064960, WS_VSTAT = WS_SSQB + 1064960;
constexpr size_t WS_SSQSA = WS_VSTAT + 6389760, WS_SSQSB = WS_SSQSA + 32768;
constexpr size_t WS_SLOTA = 9 * MiB + 256 * 1024, WS_SLOTB = WS_SLOTA + 36175872, WS_XB = WS_SLOTB + 23592960, WS_U = WS_XB + 34078720, WS_V = WS_U + 102236160, WS_END = WS_V + 102236160;
constexpr size_t WS_HID = WS_U, WS_GLU = WS_U, WS_CACT = WS_U + 33 * MiB;
static_assert((size_t)M * 96 * 4 == 6389760 && WS_SSQSB + 32768 <= WS_SLOTA, "ws map");
static_assert((size_t)M * 16 * 4 <= 1064960 && (size_t)M * D * 2 == 34078720 && (size_t)M * DSGU * 2 == 102236160, "ws map");
static_assert(WS_END <= 310173696, "ws map: must fit sum(inputs) bytes");
static_assert(WS_HID + (size_t)M * DFF * 2 <= WS_V && WS_GLU + (size_t)M * D * 2 <= WS_CACT, "ws map");
constexpr size_t SA_WIN = 0, SA_WOUT = 12582912, SA_WGU = 18874368, SA_WDN = 30408704;
constexpr size_t SB_PW1 = 0, SB_PW2 = 4194304, SB_WGU = 6291456, SB_WDN = 17825792;

constexpr int CW_BAR = 4096;

constexpr int RING_BYTES = 131072, RS_OFF = RING_BYTES  , LDSCTL_OFF = RING_BYTES + 2048, MISC_OFF = LDSCTL_OFF + 320, LDS_BYTES = 147456;

__device__ __forceinline__ unsigned cvt_pk_bf16(float lo, float hi) { unsigned r; asm volatile("v_cvt_pk_bf16_f32 %0, %1, %2" : "=v"(r) : "v"(lo), "v"(hi)); return r; }
__device__ __forceinline__ unsigned f2bf(float f) { unsigned u = __builtin_bit_cast(unsigned, f); return (u + 0x7fffu + ((u >> 16) & 1u)) >> 16; }
__device__ __forceinline__ unsigned pk2(float lo, float hi) { return f2bf(lo) | (f2bf(hi) << 16); }
__device__ __forceinline__ float bf_lo(unsigned w) { return __builtin_bit_cast(float, w << 16); }
__device__ __forceinline__ float bf_hi(unsigned w) { return __builtin_bit_cast(float, w & 0xffff0000u); }
__device__ __forceinline__ float gelu_tanh(float x) {
    const float y = x * (1.0f + 0.044715f * x * x);
    return x * __builtin_amdgcn_rcpf(1.0f + __builtin_amdgcn_exp2f(-2.302208198f * y));
}
__device__ __forceinline__ f32x2 gelu_pk(f32x2 x) {
    const f32x2 t = x * x, u = t * (-0.10294324f) + (-2.302208198f), m = x * u;
    f32x2 e; e.x = __builtin_amdgcn_exp2f(m.x); e.y = __builtin_amdgcn_exp2f(m.y);
    const f32x2 d = e + 1.0f; f32x2 r; r.x = __builtin_amdgcn_rcpf(d.x); r.y = __builtin_amdgcn_rcpf(d.y);
    return x * r;
}
__device__ __forceinline__ f32x2 sigmoid_pk(f32x2 x) {
    const f32x2 m = x * (-1.4426950409f); f32x2 e; e.x = __builtin_amdgcn_exp2f(m.x); e.y = __builtin_amdgcn_exp2f(m.y);
    const f32x2 d = e + 1.0f; f32x2 r; r.x = __builtin_amdgcn_rcpf(d.x); r.y = __builtin_amdgcn_rcpf(d.y); return r;
}
__device__ __forceinline__ f32x4 gelu4(f32x4 v) { const f32x2 a = gelu_pk((f32x2){v[0], v[1]}), b = gelu_pk((f32x2){v[2], v[3]}); return (f32x4){a.x, a.y, b.x, b.y}; }
__device__ __forceinline__ f32x4 sigmoid4(f32x4 v) { const f32x2 a = sigmoid_pk((f32x2){v[0], v[1]}), b = sigmoid_pk((f32x2){v[2], v[3]}); return (f32x4){a.x, a.y, b.x, b.y}; }
__device__ __forceinline__ float sigmoid_f(float x) { return __builtin_amdgcn_rcpf(1.0f + __builtin_amdgcn_exp2f(-1.4426950409f * x)); }
#define SHX(v, m) __builtin_bit_cast(float, __builtin_amdgcn_ds_bpermute(((lane) ^ (m)) << 2, __builtin_bit_cast(int, (float)(v))))
__device__ __forceinline__ float wave_sum(float v, int lane) {
#pragma unroll
    for (int o = 1; o < 64; o <<= 1) v += SHX(v, o);
    return v;
}
__device__ __forceinline__ size_t blk_off(int row, int col, int KT) { return ((((size_t)(row >> 8) * KT + (col >> 6)) * 256 + (row & 255)) * 64 + (col & 63)); }
#define LDS_WAIT() asm volatile("s_waitcnt lgkmcnt(0)" ::: "memory")
#define VM_WAIT() asm volatile("s_waitcnt vmcnt(0)" ::: "memory")

__device__ __forceinline__ unsigned long long karg_u64(int idx) {
    const unsigned long long k = (unsigned long long)__builtin_amdgcn_kernarg_segment_ptr(); unsigned long long v;
    asm volatile("s_load_dwordx2 %0, %1, %2\n\ts_waitcnt lgkmcnt(0)" : "=s"(v) : "s"(k), "i"(idx * 8)); return v;
}
#define KIN(idx) ((const float*)(const GAS float*)karg_u64(idx))
#define KOUT() ((float*)(GAS float*)karg_u64(25))
#define KWS() ((unsigned char*)(GAS unsigned char*)karg_u64(26))

namespace pg8 {
constexpr int BM = 256, BK = 64, HALF = 128, HTB = HALF * BK * 2, STAGE_BYTES = 8 * HTB, NXCD = 8, WGM = 8;
__host__ __device__ __forceinline__ int lds_byte(int r, int c) { const int st = (r >> 4) * 2 + (c >> 5), rr = r & 15, cc = c & 31, ob = rr * 64 + cc * 2; return st * 1024 + (ob ^ (((ob >> 9) & 1) << 5)); }
__host__ __device__ __forceinline__ void stage_rc(int b, int& R, int& C) { const int st = b / 1024, sb = b % 1024, swz = sb ^ (((sb >> 9) & 1) << 5); R = (st >> 1) * 16 + swz / 64; C = (st & 1) * 32 + (swz % 64) / 2; }
__host__ __device__ __forceinline__ int perm32(int rho) { const int n = rho >> 4, i = rho & 15; return 8 * (i >> 2) + 4 * n + (i & 3); }

struct Unit { int pm, pn; };
struct Gemm { const bf16_t* A; const bf16_t* Bt; int M, N, K; };

struct StaticOrder {
    int nM, nN, nwg, G, c, nextra;
    __device__ void init(int M_, int N_, int G_, int c_) { nM = M_ / BM; nN = N_ / BM; nextra = 0; if (nM > 64) { nextra = (nM - 64) * nN; nM = 64; } nwg = nM * nN; G = G_; c = c_; }
    __device__ bool next(int i, Unit& u) const {
        const long L = (long)i * G + c; if (L >= nwg) { if (L >= nwg + nextra) return false; u.pm = 64 + (int)(L - nwg) / nN; u.pn = (int)(L - nwg) % nN; return true; }
        int wgid = (int)L; { const int q = nwg / NXCD, r = nwg % NXCD, xcd = wgid % NXCD, off = wgid / NXCD; wgid = (xcd < r ? xcd * (q + 1) : r * (q + 1) + (xcd - r) * q) + off; }
        const int nig = WGM * nN, gid = wgid / nig, fm = gid * WGM, gsz = (nM - fm) < WGM ? (nM - fm) : WGM;
        u.pm = fm + ((wgid % nig) % gsz); u.pn = (wgid % nig) / gsz; return true;
    }
};

template <class Epi, bool ALIGN_EPI, bool SP2, bool ABLK = false>
__device__ __forceinline__ void gemm_phase(LAS unsigned char* lds, LAS float* rstab, const Gemm g, const StaticOrder& S, const Epi& E, const int tid) {
    const int wid = __builtin_amdgcn_readfirstlane(tid >> 6), lane = tid & 63, wr = wid >> 2, wc = wid & 3, fr = lane & 15, fq = lane >> 4;
    const int K = g.K, nt = K / BK;
    unsigned voffA[2], voffB[2];
#pragma unroll
    for (int i = 0; i < 2; ++i) { int R, C; stage_rc(tid * 16 + i * 8192, R, C); const int Rb = (R & ~31) + perm32(R & 31);
        voffA[i] = (unsigned)(R * (ABLK ? BK : K) + C) * 2u; voffB[i] = (unsigned)(Rb * K + C) * 2u; }
    const size_t kstep = (size_t)(BK * 2);
    const size_t hstep = (size_t)HALF * K * 2;
    const size_t tstep = 2 * hstep;
    const size_t kstepA = ABLK ? (size_t)BM * BK * 2 : kstep, hstepA = ABLK ? (size_t)HALF * BK * 2 : hstep, tstepA = ABLK ? (size_t)(K / BK) * BM * BK * 2 : tstep;
    const unsigned ldsw = (unsigned)wid * 1024u;
    const int aoff = lds_byte(wr * 64 + fr, fq * 8), boff = lds_byte(wc * 32 + fr, fq * 8);
#define PG8_SA(b, h) (((b) * 2 + (h)) * HTB)
#define PG8_SB(b, h) ((4 + (b) * 2 + (h)) * HTB)
#define PG8_STAGE(bufoff, gbase, voff) do { _Pragma("unroll") for (int _i = 0; _i < 2; ++_i) \
        __builtin_amdgcn_global_load_lds((const unsigned*)((const char*)(gbase) + (voff)[_i]), (LAS unsigned*)(lds + (bufoff) + ldsw + _i * 8192), 16, 0, 0); } while (0)
#define PG8_LDA(dst, b, h) do { _Pragma("unroll") for (int m = 0; m < 4; ++m) _Pragma("unroll") for (int k = 0; k < 2; ++k) dst[m][k] = *(const LAS bf16x8*)(lds + PG8_SA(b, h) + aoff + m * 2048 + k * 1024); } while (0)
#define PG8_LDB(dst, b, h) do { _Pragma("unroll") for (int n = 0; n < 2; ++n) _Pragma("unroll") for (int k = 0; k < 2; ++k) dst[n][k] = *(const LAS bf16x8*)(lds + PG8_SB(b, h) + boff + n * 2048 + k * 1024); } while (0)
#define PG8_MMA(ai, bj, At, Bt) do { __builtin_amdgcn_s_setprio(1); _Pragma("unroll") for (int m = 0; m < 4; ++m) _Pragma("unroll") for (int n = 0; n < 2; ++n) _Pragma("unroll") for (int k = 0; k < 2; ++k) \
        acc[ai][bj][m][n] = __builtin_amdgcn_mfma_f32_16x16x32_bf16(Bt[n][k], At[m][k], acc[ai][bj][m][n], 0, 0, 0); __builtin_amdgcn_s_setprio(0); } while (0)
#define PG8_WAIT_V(n) asm volatile("s_waitcnt vmcnt(" #n ")" ::: "memory")
#define PG8_WAIT_L(n) asm volatile("s_waitcnt lgkmcnt(" #n ")" ::: "memory")
#define PG8_BAR __builtin_amdgcn_s_barrier()
#define PG8_SCHED __builtin_amdgcn_sched_barrier(0)
#define PG8_PTRS(u, pa, pb) do { pa = (const char*)g.A + (size_t)(u).pm * tstepA; pb = (const char*)g.Bt + (size_t)(u).pn * tstep; } while (0)
    Unit cur, nxt; int ui = 0;
    if (!S.next(0, cur)) return;
    f32x4 acc[2][2][4][2];
#pragma unroll
    for (int a = 0; a < 2; ++a)
#pragma unroll
        for (int b = 0; b < 2; ++b)
#pragma unroll
            for (int m = 0; m < 4; ++m)
#pragma unroll
                for (int n = 0; n < 2; ++n) acc[a][b][m][n] = (f32x4){0.f, 0.f, 0.f, 0.f};
    bf16x8 At[4][2], B0[2][2], B1[2][2];
    const char* cA; const char* cB; PG8_PTRS(cur, cA, cB);
    if (Epi::NEEDS_RS) { if (tid < 256) E.prep(cur, rstab, tid); }
    if constexpr (SP2) {
        PG8_STAGE(PG8_SB(0, 0), cB, voffB); PG8_STAGE(PG8_SB(0, 1), cB + hstep, voffB); PG8_STAGE(PG8_SA(0, 0), cA, voffA); PG8_STAGE(PG8_SA(0, 1), cA + hstepA, voffA);
        if (wr == 1) PG8_BAR;
        PG8_WAIT_V(2); PG8_BAR;
        PG8_STAGE(PG8_SB(1, 0), cB + kstep, voffB); PG8_STAGE(PG8_SA(1, 0), cA + kstepA, voffA); PG8_STAGE(PG8_SB(1, 1), cB + hstep + kstep, voffB);
        PG8_WAIT_V(6); PG8_BAR;
    } else {
        PG8_STAGE(PG8_SB(0, 0), cB, voffB); PG8_STAGE(PG8_SA(0, 0), cA, voffA); PG8_STAGE(PG8_SB(0, 1), cB + hstep, voffB); PG8_STAGE(PG8_SA(0, 1), cA + hstepA, voffA);
        if (wr == 1) PG8_BAR;
        PG8_WAIT_V(4); PG8_BAR;
        PG8_STAGE(PG8_SB(1, 0), cB + kstep, voffB); PG8_STAGE(PG8_SA(1, 0), cA + kstepA, voffA); PG8_STAGE(PG8_SB(1, 1), cB + hstep + kstep, voffB);
        PG8_WAIT_V(6); PG8_BAR;
    }
    for (;;) {
        const bool has_next = S.next(ui + 1, nxt);
        const char* nA = cA; const char* nB = cB; if (has_next) PG8_PTRS(nxt, nA, nB);
        for (int t = 0; t < nt; t += 2) {
            const bool last = (t == nt - 2);
            const char* a1 = cA + (size_t)(t + 1) * kstepA;
            const char* a2 = last ? nA : cA + (size_t)(t + 2) * kstepA; const char* b2 = last ? nB : cB + (size_t)(t + 2) * kstep;
            const char* a3 = a2 + kstepA; const char* b3 = b2 + kstep;
            if constexpr (SP2) {
            PG8_LDB(B0, 0, 0); PG8_LDB(B1, 0, 1); PG8_SCHED; PG8_LDA(At, 0, 0);
            PG8_WAIT_V(6); PG8_WAIT_L(0); PG8_BAR; PG8_MMA(0, 0, At, B0); PG8_SCHED; PG8_STAGE(PG8_SA(1, 1), a1 + hstepA, voffA); PG8_SCHED; PG8_MMA(0, 1, At, B1); PG8_BAR; PG8_SCHED;
            PG8_LDA(At, 0, 1);
            PG8_WAIT_V(2); PG8_WAIT_L(0); PG8_BAR; PG8_MMA(1, 0, At, B0); PG8_SCHED; PG8_STAGE(PG8_SB(0, 0), b2, voffB); PG8_STAGE(PG8_SB(0, 1), b2 + hstep, voffB); PG8_STAGE(PG8_SA(0, 0), a2, voffA); PG8_SCHED; PG8_MMA(1, 1, At, B1); PG8_BAR; PG8_SCHED;
            PG8_LDB(B0, 1, 0); PG8_LDB(B1, 1, 1); PG8_SCHED; PG8_LDA(At, 1, 0);
            PG8_WAIT_V(6); PG8_WAIT_L(0); PG8_BAR; PG8_MMA(0, 0, At, B0); PG8_SCHED; PG8_STAGE(PG8_SA(0, 1), a2 + hstepA, voffA); PG8_SCHED; PG8_MMA(0, 1, At, B1); PG8_BAR; PG8_SCHED;
            PG8_LDA(At, 1, 1);
            PG8_WAIT_V(2); PG8_WAIT_L(0); PG8_BAR; PG8_MMA(1, 0, At, B0); PG8_SCHED; PG8_STAGE(PG8_SB(1, 0), b3, voffB); PG8_STAGE(PG8_SB(1, 1), b3 + hstep, voffB); PG8_STAGE(PG8_SA(1, 0), a3, voffA); PG8_SCHED; PG8_MMA(1, 1, At, B1); PG8_BAR; PG8_SCHED;
            } else {
            PG8_LDB(B0, 0, 0); PG8_SCHED; PG8_LDA(At, 0, 0); PG8_STAGE(PG8_SA(1, 1), a1 + hstepA, voffA);
            PG8_WAIT_L(8); PG8_BAR; PG8_WAIT_L(0); PG8_MMA(0, 0, At, B0); PG8_BAR; PG8_SCHED;
            PG8_LDB(B1, 0, 1); PG8_STAGE(PG8_SB(0, 0), b2, voffB);
            PG8_BAR; PG8_WAIT_L(0); PG8_MMA(0, 1, At, B1); PG8_BAR;
            PG8_LDA(At, 0, 1); PG8_STAGE(PG8_SA(0, 0), a2, voffA);
            PG8_BAR; PG8_WAIT_L(0); PG8_MMA(1, 0, At, B0); PG8_BAR; PG8_SCHED;
            PG8_STAGE(PG8_SB(0, 1), b2 + hstep, voffB);
            PG8_WAIT_V(6); PG8_BAR; PG8_MMA(1, 1, At, B1); PG8_BAR;
            PG8_LDB(B0, 1, 0); PG8_SCHED; PG8_LDA(At, 1, 0); PG8_STAGE(PG8_SA(0, 1), a2 + hstepA, voffA);
            PG8_WAIT_L(8); PG8_BAR; PG8_WAIT_L(0); PG8_MMA(0, 0, At, B0); PG8_BAR; PG8_SCHED;
            PG8_LDB(B1, 1, 1); PG8_STAGE(PG8_SB(1, 0), b3, voffB);
            PG8_BAR; PG8_WAIT_L(0); PG8_MMA(0, 1, At, B1); PG8_BAR;
            PG8_LDA(At, 1, 1); PG8_STAGE(PG8_SA(1, 0), a3, voffA);
            PG8_BAR; PG8_WAIT_L(0); PG8_MMA(1, 0, At, B0); PG8_BAR; PG8_SCHED;
            PG8_STAGE(PG8_SB(1, 1), b3 + hstep, voffB);
            PG8_WAIT_V(6); PG8_BAR; PG8_MMA(1, 1, At, B1); PG8_BAR;
            }
        }
        if constexpr (ALIGN_EPI) { if (wr == 0) PG8_BAR; }
        E(acc, cur, wr, wc, fr, fq, rstab + (ui & 1) * 256);
        if (!has_next) break;
        if (Epi::NEEDS_RS) { if (tid < 256) E.prep(nxt, rstab + ((ui + 1) & 1) * 256, tid); }
#pragma unroll
        for (int a = 0; a < 2; ++a)
#pragma unroll
            for (int b = 0; b < 2; ++b)
#pragma unroll
                for (int m = 0; m < 4; ++m)
#pragma unroll
                    for (int n = 0; n < 2; ++n) acc[a][b][m][n] = (f32x4){0.f, 0.f, 0.f, 0.f};
        cur = nxt; cA = nA; cB = nB; ++ui;
        if constexpr (ALIGN_EPI) { if (wr == 1) PG8_BAR; }
    }
    PG8_WAIT_V(0);
    if constexpr (!ALIGN_EPI) { if (wr == 0) PG8_BAR; }
    PG8_BAR;
#undef PG8_SA
#undef PG8_SB
#undef PG8_STAGE
#undef PG8_LDA
#undef PG8_LDB
#undef PG8_MMA
#undef PG8_WAIT_V
#undef PG8_WAIT_L
#undef PG8_BAR
#undef PG8_SCHED
#undef PG8_PTRS
}

__device__ __forceinline__ void rs_prep(const float* ssq, const Unit& u, LAS float* tab, int tid) {
    const f32x4* p = (const f32x4*)(ssq + (size_t)(u.pm * BM + tid) * 16);
    const f32x4 a = p[0], b = p[1], c = p[2], d = p[3];
    const f32x4 s4 = (a + b) + (c + d); const float s = (s4.x + s4.y) + (s4.z + s4.w);
    VM_WAIT();
    tab[tid] = 1.0f / sqrtf(s * (1.0f / D) + RMS_EPS);
}

struct EpiIn {
    static constexpr bool NEEDS_RS = true;
    bf16_t* U; bf16_t* V; float* vstat; const float* bias; const float* ssq;
    __device__ __forceinline__ void prep(const Unit& u, LAS float* tab, int tid) const { rs_prep(ssq, u, tab, tid); }
    __device__ __forceinline__ void operator()(f32x4 (&acc)[2][2][4][2], const Unit& u, int wr, int wc, int fr, int fq, const LAS float* tab) const { const int lane = fq * 16 + fr; (void)lane;
        const bool isv = (u.pn >= 12); const int pv = u.pn - 12;
        const int row0 = u.pm * BM + wr * 64 + fr, col0 = (isv ? pv : u.pn) * BM + wc * 32 + 8 * fq, bcol0 = u.pn * BM + wc * 32 + 8 * fq;
        bf16_t* O = isv ? V : U;
        f32x4 bv[2][2];
#pragma unroll
        for (int bj = 0; bj < 2; ++bj)
#pragma unroll
            for (int n = 0; n < 2; ++n) bv[bj][n] = *(const f32x4*)(bias + bcol0 + bj * HALF + 4 * n);
#pragma unroll
        for (int ai = 0; ai < 2; ++ai)
#pragma unroll
            for (int m = 0; m < 4; ++m) { const int rl = ai * HALF + wr * 64 + m * 16 + fr; const float rs = tab[rl];
                bf16_t* rowp = isv ? O + (size_t)(row0 + ai * HALF + m * 16) * DSGU + col0 : O + blk_off(row0 + ai * HALF + m * 16, col0, DSGU / 64);
                float sa = 0.f, sb = 0.f;
#pragma unroll
                for (int bj = 0; bj < 2; ++bj) { f32x4 v0 = acc[ai][bj][m][0] * rs + bv[bj][0], v1 = acc[ai][bj][m][1] * rs + bv[bj][1];
                    v0 = gelu4(v0); v1 = gelu4(v1);
                    u32x4 w; w.x = cvt_pk_bf16(v0[0], v0[1]); w.y = cvt_pk_bf16(v0[2], v0[3]); w.z = cvt_pk_bf16(v1[0], v1[1]); w.w = cvt_pk_bf16(v1[2], v1[3]);
                    *(u32x4*)(rowp + (isv ? bj * HALF : bj * 2 * 256 * 64)) = w;
                    if (isv) { sa += (v0[0] + v0[1]) + (v0[2] + v0[3]) + (v1[0] + v1[1]) + (v1[2] + v1[3]);
                        sb += (v0[0] * v0[0] + v0[1] * v0[1]) + (v0[2] * v0[2] + v0[3] * v0[3]) + (v1[0] * v1[0] + v1[1] * v1[1]) + (v1[2] * v1[2] + v1[3] * v1[3]);
 } }
                if (isv) { sa += SHX(sa, 16); sa += SHX(sa, 32); sb += SHX(sb, 16); sb += SHX(sb, 32);
                    if (fq == 0) *(f32x2*)(vstat + (size_t)(row0 + ai * HALF + m * 16) * 96 + (pv * 4 + wc) * 2) = (f32x2){sa, sb}; }
            }
    }
};

struct EpiRes {
    static constexpr bool NEEDS_RS = false;
    const float* base_f; bf16_t* XB; float* ssq; const float* bias; bool dry;
    __device__ __forceinline__ void prep(const Unit&, LAS float*, int) const {}
    __device__ __forceinline__ void operator()(f32x4 (&acc)[2][2][4][2], const Unit& u, int wr, int wc, int fr, int fq, const LAS float*) const { const int lane = fq * 16 + fr; (void)lane;
        const int row0 = u.pm * BM + wr * 64 + fr, col0 = u.pn * BM + wc * 32 + 8 * fq;
        f32x4 bv[2][2];
#pragma unroll
        for (int bj = 0; bj < 2; ++bj)
#pragma unroll
            for (int n = 0; n < 2; ++n) bv[bj][n] = bias ? *(const f32x4*)(bias + col0 + bj * HALF + 4 * n) : (f32x4){0.f, 0.f, 0.f, 0.f};
#pragma unroll
        for (int ai = 0; ai < 2; ++ai)
#pragma unroll
            for (int m = 0; m < 4; ++m) { const int rl = ai * HALF + m * 16; const size_t ro = (size_t)(row0 + rl) * D + col0; float qs = 0.f;
#pragma unroll
                for (int bj = 0; bj < 2; ++bj) { f32x4 b0, b1;
                    if (base_f) { b0 = *(const f32x4*)(base_f + ro + bj * HALF); b1 = *(const f32x4*)(base_f + ro + bj * HALF + 4); }
                    else { const u32x4 t = *(const u32x4*)(XB + ro + bj * HALF); b0 = (f32x4){bf_lo(t.x), bf_hi(t.x), bf_lo(t.y), bf_hi(t.y)}; b1 = (f32x4){bf_lo(t.z), bf_hi(t.z), bf_lo(t.w), bf_hi(t.w)}; }
                    const f32x4 x0 = b0 + acc[ai][bj][m][0] + bv[bj][0], x1 = b1 + acc[ai][bj][m][1] + bv[bj][1];
                    u32x4 w; w.x = cvt_pk_bf16(x0[0], x0[1]); w.y = cvt_pk_bf16(x0[2], x0[3]); w.z = cvt_pk_bf16(x1[0], x1[1]); w.w = cvt_pk_bf16(x1[2], x1[3]);
                    if (!(PROBE_MASK && dry)) *(u32x4*)(XB + ro + bj * HALF) = w;
                    qs += (x0[0] * x0[0] + x0[1] * x0[1]) + (x0[2] * x0[2] + x0[3] * x0[3]) + (x1[0] * x1[0] + x1[1] * x1[1]) + (x1[2] * x1[2] + x1[3] * x1[3]); }
                qs += SHX(qs, 16); qs += SHX(qs, 32);
                if (fq == 0) ssq[(size_t)(row0 + rl) * 16 + u.pn * 4 + wc] = qs;
                asm volatile("" ::: "memory"); }
    }
};

struct EpiGU {
    static constexpr bool NEEDS_RS = true;
    bf16_t* H; const float* ssq; const float* ssqs;
    __device__ __forceinline__ void prep(const Unit& u, LAS float* tab, int tid) const {
        if (u.pm < MP / BM) rs_prep(ssq, u, tab, tid);
        else { const f32x4* p = (const f32x4*)(ssqs + (size_t)tid * 32); f32x4 a = p[0];
#pragma unroll
            for (int k = 1; k < 8; ++k) a += p[k];
            VM_WAIT(); tab[tid] = 1.0f / sqrtf(((a.x + a.y) + (a.z + a.w)) * (1.0f / D) + RMS_EPS); } }
    __device__ __forceinline__ void operator()(f32x4 (&acc)[2][2][4][2], const Unit& u, int wr, int wc, int fr, int fq, const LAS float* tab) const { const int lane = fq * 16 + fr; (void)lane;
        const int row0 = u.pm * BM + wr * 64 + fr, col0 = u.pn * HALF + wc * 32 + 8 * fq;
#pragma unroll
        for (int ai = 0; ai < 2; ++ai)
#pragma unroll
            for (int m = 0; m < 4; ++m) { const float rs = tab[ai * HALF + wr * 64 + m * 16 + fr];
                f32x4 h[2];
#pragma unroll
                for (int n = 0; n < 2; ++n) { const f32x4 gg = acc[ai][0][m][n] * rs, uu = acc[ai][1][m][n] * rs; h[n] = gg * sigmoid4(gg) * uu; }
                u32x4 w; w.x = cvt_pk_bf16(h[0][0], h[0][1]); w.y = cvt_pk_bf16(h[0][2], h[0][3]); w.z = cvt_pk_bf16(h[1][0], h[1][1]); w.w = cvt_pk_bf16(h[1][2], h[1][3]);
                *(u32x4*)(H + blk_off(row0 + ai * HALF + m * 16, col0, DFF / 64)) = w; }
    }
};

struct EpiGLU {
    static constexpr bool NEEDS_RS = true;
    bf16_t* G; const float* ssq; const float* bias; float* out_cp;
    __device__ __forceinline__ void prep(const Unit& u, LAS float* tab, int tid) const { rs_prep(ssq, u, tab, tid); }
    __device__ __forceinline__ void operator()(f32x4 (&acc)[2][2][4][2], const Unit& u, int wr, int wc, int fr, int fq, const LAS float* tab) const { const int lane = fq * 16 + fr; (void)lane;
        const int row0 = u.pm * BM + wr * 64 + fr, col0 = u.pn * HALF + wc * 32 + 8 * fq;
        f32x4 ba[2], bg[2];
#pragma unroll
        for (int n = 0; n < 2; ++n) { ba[n] = *(const f32x4*)(bias + col0 + 4 * n); bg[n] = *(const f32x4*)(bias + D + col0 + 4 * n); }
#pragma unroll
        for (int ai = 0; ai < 2; ++ai)
#pragma unroll
            for (int m = 0; m < 4; ++m) { const float rs = tab[ai * HALF + wr * 64 + m * 16 + fr]; const int r = row0 + ai * HALF + m * 16;
                f32x4 o[2];
#pragma unroll
                for (int n = 0; n < 2; ++n) { const f32x4 a = acc[ai][0][m][n] * rs + ba[n], gt = acc[ai][1][m][n] * rs + bg[n];
                    o[n] = a * sigmoid4(gt); }
                u32x4 w; w.x = cvt_pk_bf16(o[0][0], o[0][1]); w.y = cvt_pk_bf16(o[0][2], o[0][3]); w.z = cvt_pk_bf16(o[1][0], o[1][1]); w.w = cvt_pk_bf16(o[1][2], o[1][3]);
                *(u32x4*)(G + (size_t)r * D + col0) = w;
                { const int t = r & 4095; if (t >= 4066) { float* dst = out_cp + ((size_t)(r >> 12) * 30 + (t - 4066)) * D + col0; *(f32x4*)dst = o[0]; *(f32x4*)(dst + 4) = o[1]; } }
            }
    }
};
}

namespace thin {
template <int NF, bool ABLK = false>
__device__ __forceinline__ void unit_mma(const bf16_t* Abase, int arow, int K, const bf16_t* const (&B)[NF], int tid, int wave, int lane, LAS unsigned char* lds, f32x4 (&red)[NF]) {
    f32x4 acc[2][NF];
#pragma unroll
    for (int m = 0; m < 2; ++m)
#pragma unroll
        for (int n = 0; n < NF; ++n) acc[m][n] = (f32x4){0.f, 0.f, 0.f, 0.f};
    const int kw = K >> 3, nks = kw >> 5, kb = wave * kw;
    constexpr int CH = (NF == 2) ? 12 : 4;
    for (int k0 = 0; k0 < nks; k0 += CH) {
        bf16x8 a[2][CH], b[NF][CH];
#pragma unroll
        for (int s = 0; s < CH; ++s) if (k0 + s < nks) {
#pragma unroll
            for (int m = 0; m < 2; ++m) { const int kk = kb + 32 * (k0 + s) + 8 * (lane >> 4);
                a[m][s] = *(const bf16x8*)(ABLK ? Abase + blk_off(arow + 16 * m, kk, K >> 6) : Abase + (size_t)(arow + 16 * m) * K + kk); }
#pragma unroll
            for (int n = 0; n < NF; ++n) b[n][s] = *(const bf16x8*)(B[n] + kb + 32 * (k0 + s)); }
#pragma unroll
        for (int s = 0; s < CH; ++s) if (k0 + s < nks) {
#pragma unroll
            for (int m = 0; m < 2; ++m)
#pragma unroll
                for (int n = 0; n < NF; ++n) acc[m][n] = __builtin_amdgcn_mfma_f32_16x16x32_bf16(b[n][s], a[m][s], acc[m][n], 0, 0, 0); }
    }
    __syncthreads();
    LAS f32x4* P = (LAS f32x4*)lds;
#pragma unroll
    for (int m = 0; m < 2; ++m)
#pragma unroll
        for (int n = 0; n < NF; ++n) P[(wave * 2 * NF + m * NF + n) * 64 + lane] = acc[m][n];
    __syncthreads();
    if (tid < 128) { const int m = tid >> 6;
#pragma unroll
        for (int n = 0; n < NF; ++n) { f32x4 s = P[(m * NF + n) * 64 + lane];
#pragma unroll
            for (int w = 1; w < 8; ++w) s += P[(w * 2 * NF + m * NF + n) * 64 + lane];
            red[n] = s; } }
}
__device__ __forceinline__ float rs_of(const float* ssqs, int r) {
    const f32x4* p = (const f32x4*)(ssqs + (size_t)r * 32); f32x4 a = p[0];
#pragma unroll
    for (int k = 1; k < 8; ++k) a += p[k];
    return 1.0f / sqrtf(((a.x + a.y) + (a.z + a.w)) * (1.0f / D) + RMS_EPS);
}
__device__ __forceinline__ u32x2 pk4(f32x4 v) { u32x2 w; w.x = cvt_pk_bf16(v[0], v[1]); w.y = cvt_pk_bf16(v[2], v[3]); return w; }

__device__ __forceinline__ int xcd_unit(int t, int G, int per) {
    if (G != 256) return t;
    const int x = t & 7, q = (t & 255) >> 3, i = t >> 8, l = q * per + i;
    return ((x + 8 * (l >> 3)) << 3) | (l & 7);
}
__device__ __forceinline__ void t_in(int unit, int tid, int wave, int lane, LAS unsigned char* lds, const bf16_t* XB, const bf16_t* W, const float* bias, const float* ssqs, bf16_t* U, bf16_t* V, float* vstat, float* vraw) {
    const int fr = lane & 15, fq = lane >> 4, s = unit & 7, cb = unit >> 3, c0 = 64 * cb;
    const bf16_t* const B[4] = {W + (size_t)(c0 + fr) * D + 8 * fq, W + (size_t)(c0 + 16 + fr) * D + 8 * fq, W + (size_t)(c0 + 32 + fr) * D + 8 * fq, W + (size_t)(c0 + 48 + fr) * D + 8 * fq};
    const int r = 32 * s + 16 * ((tid >> 6) & 1) + fr; float rs = 0.f; f32x4 bv[4];
    if (tid < 128) { rs = rs_of(ssqs, r);
#pragma unroll
        for (int n = 0; n < 4; ++n) bv[n] = *(const f32x4*)(bias + c0 + 16 * n + 4 * fq); }
    f32x4 red[4]; unit_mma<4>(XB, MP + 32 * s + fr, D, B, tid, wave, lane, lds, red);
    if (tid < 128) { const bool isv = (cb >= 48); const int oc = (isv ? c0 - DSGU : c0) + 4 * fq; bf16_t* O = isv ? V : U;
        float sa = 0.f, sb = 0.f;
#pragma unroll
        for (int n = 0; n < 4; ++n) { f32x4 v = red[n] * rs + bv[n];
#pragma unroll
            for (int j = 0; j < 4; ++j) v[j] = gelu_tanh(v[j]);
            *(u32x2*)(isv ? O + (size_t)(MP + r) * DSGU + oc + 16 * n : O + blk_off(MP + r, oc + 16 * n, DSGU / 64)) = pk4(v);
            if (isv) { *(f32x4*)(vraw + (size_t)r * DSGU + oc + 16 * n) = v; sa += (v[0] + v[1]) + (v[2] + v[3]); sb += (v[0] * v[0] + v[1] * v[1]) + (v[2] * v[2] + v[3] * v[3]); } }
        if (isv) { sa += SHX(sa, 16); sa += SHX(sa, 32); sb += SHX(sb, 16); sb += SHX(sb, 32);
            if (fq == 0) *(f32x2*)(vstat + (size_t)(MP + r) * 96 + (cb - 48) * 2) = (f32x2){sa, sb}; } }
}
__device__ __forceinline__ void t_in_unit(const bf16x8 (&a)[2][4], const bf16x8 (&bb)[4][4], int s, int cb, float rs, int tid, int wave, int lane, LAS unsigned char* lds, const float* bias, bf16_t* U, bf16_t* V, float* vstat, float* vraw) {
    const int fr = lane & 15, fq = lane >> 4, c0 = 64 * cb, r = 32 * s + 16 * ((tid >> 6) & 1) + fr; f32x4 bv[4];
    if (tid < 128) {
#pragma unroll
        for (int n = 0; n < 4; ++n) bv[n] = *(const f32x4*)(bias + c0 + 16 * n + 4 * fq); }
    f32x4 acc[2][4];
#pragma unroll
    for (int m = 0; m < 2; ++m)
#pragma unroll
        for (int n = 0; n < 4; ++n) acc[m][n] = (f32x4){0.f, 0.f, 0.f, 0.f};
#pragma unroll
    for (int ks = 0; ks < 4; ++ks)
#pragma unroll
        for (int m = 0; m < 2; ++m)
#pragma unroll
            for (int n = 0; n < 4; ++n) acc[m][n] = __builtin_amdgcn_mfma_f32_16x16x32_bf16(bb[n][ks], a[m][ks], acc[m][n], 0, 0, 0);
    __syncthreads();
    LAS f32x4* P = (LAS f32x4*)lds;
#pragma unroll
    for (int m = 0; m < 2; ++m)
#pragma unroll
        for (int n = 0; n < 4; ++n) P[(wave * 8 + m * 4 + n) * 64 + lane] = acc[m][n];
    __syncthreads();
    if (tid < 128) { const int m = tid >> 6; const bool isv = (cb >= 48); const int oc = (isv ? c0 - DSGU : c0) + 4 * fq; bf16_t* O = isv ? V : U;
        float sa = 0.f, sb = 0.f;
#pragma unroll
        for (int n = 0; n < 4; ++n) { f32x4 v = P[(m * 4 + n) * 64 + lane];
#pragma unroll
            for (int w = 1; w < 8; ++w) v += P[(w * 8 + m * 4 + n) * 64 + lane];
            v = v * rs + bv[n];
#pragma unroll
            for (int j = 0; j < 4; ++j) v[j] = gelu_tanh(v[j]);
            *(u32x2*)(isv ? O + (size_t)(MP + r) * DSGU + oc + 16 * n : O + blk_off(MP + r, oc + 16 * n, DSGU / 64)) = pk4(v);
            if (isv) { *(f32x4*)(vraw + (size_t)r * DSGU + oc + 16 * n) = v; sa += (v[0] + v[1]) + (v[2] + v[3]); sb += (v[0] * v[0] + v[1] * v[1]) + (v[2] * v[2] + v[3] * v[3]); } }
        if (isv) { sa += SHX(sa, 16); sa += SHX(sa, 32); sb += SHX(sb, 16); sb += SHX(sb, 32);
            if (fq == 0) *(f32x2*)(vstat + (size_t)(MP + r) * 96 + (cb - 48) * 2) = (f32x2){sa, sb}; } }
}
#define T_IN_LOADB(dst, cb_) _Pragma("unroll") for (int n = 0; n < 4; ++n) _Pragma("unroll") for (int ks = 0; ks < 4; ++ks) dst[n][ks] = *(const bf16x8*)(W + (size_t)(64 * (cb_) + 16 * n + fr) * D + kq + 32 * ks)
__device__ __forceinline__ void t_in3(int b, int tid, int wave, int lane, LAS unsigned char* lds, const bf16_t* XB, const bf16_t* W, const float* bias, const float* ssqs, bf16_t* U, bf16_t* V, float* vstat, float* vraw) {
    const int fr = lane & 15, fq = lane >> 4, s = b & 7, cbA = b >> 3, kq = wave * 128 + 8 * fq;
    bf16x8 a[2][4], b0[4][4], b1[4][4];
#pragma unroll
    for (int m = 0; m < 2; ++m)
#pragma unroll
        for (int ks = 0; ks < 4; ++ks) a[m][ks] = *(const bf16x8*)(XB + (size_t)(MP + 32 * s + 16 * m + fr) * D + kq + 32 * ks);
    T_IN_LOADB(b0, cbA); T_IN_LOADB(b1, cbA + 32);
    const float rs = (tid < 128) ? rs_of(ssqs, 32 * s + 16 * ((tid >> 6) & 1) + fr) : 0.f;
    t_in_unit(a, b0, s, cbA, rs, tid, wave, lane, lds, bias, U, V, vstat, vraw);
    T_IN_LOADB(b0, cbA + 64);
    t_in_unit(a, b1, s, cbA + 32, rs, tid, wave, lane, lds, bias, U, V, vstat, vraw);
    t_in_unit(a, b0, s, cbA + 64, rs, tid, wave, lane, lds, bias, U, V, vstat, vraw);
}
#undef T_IN_LOADB
__device__ __forceinline__ void t_res(int unit, int tid, int wave, int lane, LAS unsigned char* lds, const bf16_t* A, int K, const bf16_t* W, const float* bias, const float* base_f, bf16_t* XB, float* ssqs_out, bool dry, bool ablk) {
    const int fr = lane & 15, fq = lane >> 4, s = unit & 7, cb = unit >> 3, c0 = 32 * cb;
    const bf16_t* const B[2] = {W + (size_t)(c0 + fr) * K + 8 * fq, W + (size_t)(c0 + 16 + fr) * K + 8 * fq};
    const int r = 32 * s + 16 * ((tid >> 6) & 1) + fr; f32x4 xb[2];
    if (tid < 128) {
#pragma unroll
        for (int n = 0; n < 2; ++n) { const int c = c0 + 16 * n + 4 * fq;
            if (base_f) xb[n] = *(const f32x4*)(base_f + (size_t)r * D + c);
            else { const u32x2 t = *(const u32x2*)(XB + (size_t)(MP + r) * D + c); xb[n] = (f32x4){bf_lo(t.x), bf_hi(t.x), bf_lo(t.y), bf_hi(t.y)}; }
            if (bias) xb[n] += *(const f32x4*)(bias + c); } }
    f32x4 red[2]; if (ablk) unit_mma<2, true>(A, MP + 32 * s + fr, K, B, tid, wave, lane, lds, red); else unit_mma<2, false>(A, MP + 32 * s + fr, K, B, tid, wave, lane, lds, red);
    if (tid < 128) { float q = 0.f;
#pragma unroll
        for (int n = 0; n < 2; ++n) { const int c = c0 + 16 * n + 4 * fq; f32x4 x = xb[n] + red[n];
            if (!(PROBE_MASK && dry)) *(u32x2*)(XB + (size_t)(MP + r) * D + c) = pk4(x);
            q += (x[0] * x[0] + x[1] * x[1]) + (x[2] * x[2] + x[3] * x[3]); }
        q += SHX(q, 16); q += SHX(q, 32);
        if (fq == 0) ssqs_out[(size_t)r * 32 + cb] = q; }
}
__device__ __forceinline__ void t_gu(int unit, int tid, int wave, int lane, LAS unsigned char* lds, const bf16_t* XB, const bf16_t* W, const float* ssqs, bf16_t* H) {
    const int fr = lane & 15, fq = lane >> 4, s = unit & 7, hb = unit >> 3, h0 = 32 * hb, wrow = 256 * (h0 >> 7) + (h0 & 127) + fr;
    const bf16_t* const B[4] = {W + (size_t)wrow * D + 8 * fq, W + (size_t)(wrow + 16) * D + 8 * fq, W + (size_t)(wrow + 128) * D + 8 * fq, W + (size_t)(wrow + 144) * D + 8 * fq};
    f32x4 red[4]; unit_mma<4>(XB, MP + 32 * s + fr, D, B, tid, wave, lane, lds, red);
    if (tid < 128) { const int r = 32 * s + 16 * (tid >> 6) + fr; const float rs = rs_of(ssqs, r);
#pragma unroll
        for (int n = 0; n < 2; ++n) { f32x4 h;
#pragma unroll
            for (int j = 0; j < 4; ++j) { const float gg = red[n][j] * rs, uu = red[n + 2][j] * rs; h[j] = gg * sigmoid_f(gg) * uu; }
            *(u32x2*)(H + (size_t)(MP + r) * DFF + h0 + 16 * n + 4 * fq) = pk4(h); } }
}
__device__ __forceinline__ void t_glu(int unit, int tid, int wave, int lane, LAS unsigned char* lds, const bf16_t* XB, const bf16_t* W, const float* bias, const float* ssqs, bf16_t* G, float* out_cs) {
    const int fr = lane & 15, fq = lane >> 4, s = unit & 7, cb = unit >> 3, c0 = 32 * cb, wrow = 256 * (c0 >> 7) + (c0 & 127) + fr;
    const bf16_t* const B[4] = {W + (size_t)wrow * D + 8 * fq, W + (size_t)(wrow + 16) * D + 8 * fq, W + (size_t)(wrow + 128) * D + 8 * fq, W + (size_t)(wrow + 144) * D + 8 * fq};
    const int r = 32 * s + 16 * ((tid >> 6) & 1) + fr; float rs = 0.f; f32x4 bv[4];
    if (tid < 128) { rs = rs_of(ssqs, r);
#pragma unroll
        for (int n = 0; n < 2; ++n) { bv[n] = *(const f32x4*)(bias + c0 + 16 * n + 4 * fq); bv[n + 2] = *(const f32x4*)(bias + D + c0 + 16 * n + 4 * fq); } }
    f32x4 red[4]; unit_mma<4>(XB, MP + 32 * s + fr, D, B, tid, wave, lane, lds, red);
    if (tid < 128) { const int tt = r & 31;
#pragma unroll
        for (int n = 0; n < 2; ++n) { const int c = c0 + 16 * n + 4 * fq; const f32x4 a = red[n] * rs + bv[n], gt = red[n + 2] * rs + bv[n + 2]; f32x4 o;
#pragma unroll
            for (int j = 0; j < 4; ++j) o[j] = a[j] * sigmoid_f(gt[j]);
            *(u32x2*)(G + (size_t)(MP + r) * D + c) = pk4(o);
            if (tt >= 2) *(f32x4*)(out_cs + ((size_t)(r >> 5) * 30 + (tt - 2)) * D + c) = o; } }
}
}

#define XB_TMO      128
#define XB_XCNT(j)  (256  + 64 * (j))
#define XB_XSUB(j)  (1280 + 64 * (j))
#define XB_XGEN(j)  (2304 + 64 * (j))
#define XB_TOP      3328
#define XB_TOPGEN   3392
#define XCD_BAR_WORDS 3456
#define XB_SPIN_CAP (1u << 18)
__device__ __forceinline__ unsigned xb_ld(unsigned* p)              { return __hip_atomic_load(p, __ATOMIC_RELAXED, __HIP_MEMORY_SCOPE_AGENT); }
__device__ __forceinline__ unsigned xb_add(unsigned* p, unsigned v) { return __hip_atomic_fetch_add(p, v, __ATOMIC_RELAXED, __HIP_MEMORY_SCOPE_AGENT); }
__device__ __forceinline__ unsigned xb_xcc_id() { return (unsigned)__builtin_amdgcn_s_getreg((3 << 11) | 20) & 0xFu; }
#define XB_SPIN(cond, bar) do { unsigned _sp = 0; while (cond) { __builtin_amdgcn_s_sleep(1); \
    if ((++_sp & 255u) == 0u) { if (xb_ld(&(bar)[XB_TMO])) break; if (_sp > XB_SPIN_CAP) { atomicAdd(&(bar)[XB_TMO], 1u); break; } } } } while (0)
struct XcdBarrier { unsigned* bar; unsigned x; volatile LAS unsigned* st; };
__device__ __forceinline__ XcdBarrier xcd_barrier_post(unsigned* bar, volatile LAS unsigned* st) {
    XcdBarrier b; b.bar = bar; b.x = xb_xcc_id(); b.st = st;
    if (threadIdx.x == 0) (void)xb_add(&bar[XB_XCNT(b.x)], 1u);
    return b;
}
__device__ __forceinline__ void xcd_barrier_complete(unsigned* bar, unsigned x, unsigned& nloc, unsigned& nx) {
    const unsigned G = gridDim.x * gridDim.y * gridDim.z;
    unsigned sum, cnt, mine, sp = 0u;
    for (;;) {
        sum = 0u; cnt = 0u; mine = 0u;
#pragma unroll
        for (unsigned j = 0; j < 16; ++j) { const unsigned c = xb_ld(&bar[XB_XCNT(j)]); sum += c; cnt += (c > 0u) ? 1u : 0u; mine = (j == x) ? c : mine; }
        if (sum == G) break;
        __builtin_amdgcn_s_sleep(1);
        if ((++sp & 255u) == 0u) { if (xb_ld(&bar[XB_TMO])) break; if (sp > XB_SPIN_CAP) { atomicAdd(&bar[XB_TMO], 1u); break; } }
    }
    nloc = mine > 0u ? mine : 1u; nx = cnt > 0u ? cnt : 1u;
}
__device__ __forceinline__ void xcd_barrier(const XcdBarrier& b) {
    asm volatile("s_waitcnt vmcnt(0)" ::: "memory");
    __syncthreads();
    if (threadIdx.x == 0) {
        unsigned long long bar_i = (unsigned long long)b.bar; asm volatile("" : "+v"(bar_i)); unsigned* bar = (unsigned*)(GAS unsigned*)bar_i;
        __builtin_amdgcn_s_waitcnt(0);
        unsigned nloc = b.st[0], nx = b.st[1];
        if (nloc == 0u) { xcd_barrier_complete(bar, b.x, nloc, nx); b.st[0] = nloc; b.st[1] = nx; }
        const unsigned old = xb_add(&bar[XB_XSUB(b.x)], 1u);
        const unsigned gen = old / nloc;
        if (old + 1u == (gen + 1u) * nloc) {
            __builtin_amdgcn_fence(__ATOMIC_RELEASE, "agent");
            asm volatile("s_waitcnt vmcnt(0)" ::: "memory");
            const unsigned og = xb_add(&bar[XB_TOP], 1u);
            const unsigned tg = og / nx;
            if (og + 1u == (tg + 1u) * nx) xb_add(&bar[XB_TOPGEN], 1u);
            else XB_SPIN(xb_ld(&bar[XB_TOPGEN]) == tg, bar);
            xb_add(&bar[XB_XGEN(b.x)], 1u);
            __builtin_amdgcn_fence(__ATOMIC_ACQUIRE, "agent");
            asm volatile("s_waitcnt vmcnt(0)" ::: "memory");
        } else {
            XB_SPIN(xb_ld(&bar[XB_XGEN(b.x)]) == gen, bar);
            __builtin_amdgcn_fence(__ATOMIC_ACQUIRE, "agent");
            asm volatile("s_waitcnt vmcnt(0)" ::: "memory");
        }
    }
    __syncthreads();
}

struct Args { const float* in[25]; float* out; unsigned char* ws; int ph_lo, ph_hi, li, pad; };
enum { I_XP = 0, I_XS, I_STATE, I_GMIX, I_GFFN, I_GFIN, I_WIN, I_BIN, I_LNG, I_LNB, I_WS, I_BS, I_WOUT, I_BOUT, I_PW1, I_BPW1, I_WDW, I_BDW, I_CLNG, I_CLNB, I_PW2, I_BPW2, I_WG, I_WU, I_WD };

__device__ __forceinline__ void cvt_item(const float* W, int K, int N, const float* gsc, bf16_t* WT, int kind, LAS float* scr, int item, int lane) {
    const int nblk = N / 32, kb = item / nblk, nb = item % nblk, k0 = 64 * kb, n0 = 32 * nb;
    int row0 = n0;
    if (kind == 1) row0 = 256 * (n0 >> 7) + (n0 & 127);
    else if (kind == 2) row0 = 256 * (n0 >> 7) + (n0 & 127) + 128;
    else if (kind == 3) { const int n1 = n0 & 1023; row0 = 256 * (n1 >> 7) + (n1 & 127) + ((n0 >= 1024) ? 128 : 0); }
    float wv[32];
#pragma unroll
    for (int i = 0; i < 32; ++i) wv[i] = __builtin_nontemporal_load(&W[(size_t)(k0 + 2 * i + (lane >> 5)) * N + n0 + (lane & 31)]);
    if (gsc) {
#pragma unroll
        for (int i = 0; i < 32; ++i) wv[i] *= gsc[k0 + 2 * i + (lane >> 5)]; }
#pragma unroll
    for (int i = 0; i < 32; ++i) scr[(2 * i + (lane >> 5)) * 33 + (lane & 31)] = wv[i];
    LDS_WAIT(); asm volatile("" ::: "memory");
    const int c = lane & 7;
#pragma unroll
    for (int j = 0; j < 4; ++j) { const int n = (lane >> 3) + 8 * j; const LAS float* s = scr + (8 * c) * 33 + n;
        u32x4 o; o.x = pk2(s[0 * 33], s[1 * 33]); o.y = pk2(s[2 * 33], s[3 * 33]); o.z = pk2(s[4 * 33], s[5 * 33]); o.w = pk2(s[6 * 33], s[7 * 33]);
        *(u32x4*)(WT + (size_t)(row0 + n) * K + k0 + 8 * c) = o; }
    LDS_WAIT(); asm volatile("" ::: "memory");
}
__device__ __forceinline__ void convert_layer(int L, LAS unsigned char* lds, int gw, int NGW, int wave, int lane) {
    LAS float* scr = (LAS float*)(lds + wave * 16384);
    const int j = L >> 1; const bool sgu = !(L & 1);
    unsigned char* slot = KWS() + (sgu ? WS_SLOTA : WS_SLOTB);
    const float* w0 = sgu ? KIN(I_WIN) + (size_t)j * D * DSF : KIN(I_PW1) + (size_t)j * D * 2 * D;
    const float* w1 = sgu ? KIN(I_WOUT) + (size_t)j * DSGU * D : KIN(I_PW2) + (size_t)j * D * D;
    const int N0 = sgu ? DSF : 2 * D, K1 = sgu ? DSGU : D;
    const int I0 = (D / 64) * (N0 / 32), I1 = (K1 / 64) * (D / 32), IG = (D / 64) * (DFF / 32), ID = (DFF / 64) * (D / 32);
    bf16_t* d0 = (bf16_t*)(slot + (sgu ? SA_WIN : SB_PW1)); bf16_t* d1 = (bf16_t*)(slot + (sgu ? SA_WOUT : SB_PW2));
    bf16_t* dg = (bf16_t*)(slot + (sgu ? SA_WGU : SB_WGU)); bf16_t* dd = (bf16_t*)(slot + (sgu ? SA_WDN : SB_WDN));
    const float* gmix = KIN(I_GMIX) + L * D; const float* gffn = KIN(I_GFFN) + L * D;
    const int total = I0 + I1 + 2 * IG + ID;
    for (int it = gw; it < total; it += NGW) {
        int r = it; asm volatile("" : "+v"(r));
        if (r < I0) { cvt_item(w0, D, N0, gmix, d0, sgu ? 0 : 3, scr, r, lane); continue; } r -= I0;
        if (r < I1) { cvt_item(w1, K1, D, nullptr, d1, 0, scr, r, lane); continue; } r -= I1;
        if (r < IG) { cvt_item(KIN(I_WG) + (size_t)L * D * DFF, D, DFF, gffn, dg, 1, scr, r, lane); continue; } r -= IG;
        if (r < IG) { cvt_item(KIN(I_WU) + (size_t)L * D * DFF, D, DFF, gffn, dg, 2, scr, r, lane); continue; } r -= IG;
        cvt_item(KIN(I_WD) + (size_t)L * DFF * D, DFF, D, nullptr, dd, 0, scr, r, lane);
    }
    __syncthreads();
}

__device__ __forceinline__ void p0_rows(int gw, int NGW, int lane) {
    unsigned char* ws = KWS(); bf16_t* XB = (bf16_t*)(ws + WS_XB); float* ssq = (float*)(ws + WS_SSQA); float* ssqs = (float*)(ws + WS_SSQSA);
    for (int m = gw; m < M; m += NGW) {
        const float* xrow = (m < MP) ? KIN(I_XP) + (size_t)m * D : KIN(I_XS) + (size_t)(m - MP) * D;
        const f32x4* xr = (const f32x4*)xrow + lane; f32x4 v[4]; float s = 0.f;
#pragma unroll
        for (int jj = 0; jj < 4; ++jj) { v[jj] = __builtin_nontemporal_load(xr + 64 * jj); s += (v[jj].x * v[jj].x + v[jj].y * v[jj].y) + (v[jj].z * v[jj].z + v[jj].w * v[jj].w); }
        s = wave_sum(s, lane);
        u32x2* o8 = (u32x2*)(XB + (size_t)m * D) + lane;
#pragma unroll
        for (int jj = 0; jj < 4; ++jj) { u32x2 w; w.x = pk2(v[jj].x, v[jj].y); w.y = pk2(v[jj].z, v[jj].w); o8[64 * jj] = w; }
        if (m < MP) { if (lane < 16) ssq[(size_t)m * 16 + lane] = (lane == 0) ? s : 0.f; }
        else if (lane < 32) ssqs[(size_t)(m - MP) * 32 + lane] = (lane == 0) ? s : 0.f;
    }
}

__device__ __forceinline__ void final_rows(int gw, int NGW, int lane, bool dry) {
    float* Y = KOUT(); unsigned char* ws = KWS(); const bf16_t* XB = (const bf16_t*)(ws + WS_XB); const float* ssq = (const float*)(ws + WS_SSQA); const float* ssqs = (const float*)(ws + WS_SSQSA); const float* gf = KIN(I_GFIN);
    f32x4 gv[4];
#pragma unroll
    for (int jj = 0; jj < 4; ++jj) gv[jj] = ((const f32x4*)gf)[lane + 64 * jj];
    for (int m = gw; m < M; m += NGW) {
        const float p = (m < MP) ? ((lane < 16) ? ssq[(size_t)m * 16 + lane] : 0.f) : ((lane < 32) ? ssqs[(size_t)(m - MP) * 32 + lane] : 0.f);
        const u32x2* xr = (const u32x2*)(XB + (size_t)m * D) + lane; u32x2 t[4];
#pragma unroll
        for (int jj = 0; jj < 4; ++jj) t[jj] = __builtin_nontemporal_load(xr + 64 * jj);
        const float s = wave_sum(p, lane); const float rs = 1.0f / sqrtf(s * (1.0f / D) + RMS_EPS);
        f32x4* yr = (f32x4*)(Y + (size_t)m * D) + lane;
#pragma unroll
        for (int jj = 0; jj < 4; ++jj) { const f32x4 v = (f32x4){bf_lo(t[jj].x), bf_hi(t[jj].x), bf_lo(t[jj].y), bf_hi(t[jj].y)}; if (!(PROBE_MASK && dry)) __builtin_nontemporal_store(v * rs * gv[jj], yr + 64 * jj); }
    }
}

__device__ __forceinline__ void sample_v_rows(int j, int gw, int NGW, int lane, bool dry) {
    float* vr = KOUT() + O_SV + (size_t)j * MS * DSGU; const float* vstat = (const float*)(KWS() + WS_VSTAT);
    const float* g = KIN(I_LNG) + j * DSGU; const float* b = KIN(I_LNB) + j * DSGU;
    for (int r = gw; r < MS; r += NGW) {
        float s = 0.f, q = 0.f;
        if (lane < 48) { const f32x2 p = *(const f32x2*)(vstat + (size_t)(MP + r) * 96 + lane * 2); s = p.x; q = p.y; }
        s = wave_sum(s, lane); q = wave_sum(q, lane);
        const float mean = s * (1.0f / DSGU), var = q * (1.0f / DSGU) - mean * mean, rstd = 1.0f / sqrtf(var + LN_EPS);
        f32x4* row = (f32x4*)(vr + (size_t)r * DSGU);
        for (int k = lane; k < DSGU / 4; k += 64) { const f32x4 v = row[k]; if (!(PROBE_MASK && dry)) row[k] = (v - mean) * rstd * ((const f32x4*)g)[k] + ((const f32x4*)b)[k]; }
    }
}

constexpr int MIX_ITEMS = 512 + 24;
constexpr int MIX_VS = 520;
constexpr int MIX_WP = 0, MIX_MU = 34816, MIX_RS = 35328, MIX_C1 = 35840, MIX_C2 = 36352, MIX_V = 36864;
constexpr int MIX_LG = MIX_V + 128 * MIX_VS, MIX_LB = MIX_LG + 3072;
constexpr int MIX_BSV = MIX_LB + 3072;
static_assert(MIX_BSV + 512 <= RING_BYTES, "mix LDS map");
__device__ __forceinline__ void mix_decode(int item, int& c, int& hd, int& tb, int& te) {
    if (item < 512) { c = item >> 2; hd = item & 3; tb = 0; te = 3; } else { const int q = item - 512; c = 128 + q / 12; hd = (q % 12) / 3; tb = q % 3; te = tb + 1; }
}
#define MIX_LOAD_V(c_, hd_, t3_) _Pragma("unroll") for (int i = 0; i < 8; ++i) { const int p = tid + 512 * i, row = p >> 5, c16 = p & 31; vreg[i] = __builtin_nontemporal_load((const u32x4*)(V + (size_t)(128 * (c_) + row) * DSGU + 768 * (hd_) + 256 * (t3_) + 8 * c16)); }
#define MIX_LOAD_U(dst, c_, hd_, t3_) _Pragma("unroll") for (int mi = 0; mi < 8; ++mi) dst[mi] = *(const u32x4*)(U + blk_off(128 * (c_) + 16 * mi + fr, 768 * (hd_) + 256 * (t3_) + 32 * wave + 8 * fq, DSGU / 64))
__device__ __forceinline__ void mix_phase(int j, LAS unsigned char* lds, int tid, int wave, int lane, int c0, int G, bool dry) {
    const float* Wsl = KIN(I_WS) + (size_t)j * 4 * 128 * 128; const float* bs = KIN(I_BS) + j * 4 * 128;
    const float* lng = KIN(I_LNG) + j * DSGU; const float* lnb = KIN(I_LNB) + j * DSGU;
    unsigned char* ws = KWS();
    const float* vstat = (const float*)(ws + WS_VSTAT); bf16_t* U = (bf16_t*)(ws + WS_U); const bf16_t* V = (const bf16_t*)(ws + WS_V);
    LAS float* mu = (LAS float*)(lds + MIX_MU); LAS float* rsd = (LAS float*)(lds + MIX_RS); LAS float* c1 = (LAS float*)(lds + MIX_C1); LAS float* c2 = (LAS float*)(lds + MIX_C2);
    const int fr = lane & 15, fq = lane >> 4;
    int item = c0, c, hd, tb, te; mix_decode(item, c, hd, tb, te); int t3 = tb; bool newitem = true, more = (item < MIX_ITEMS);
    u32x4 vreg[8], ureg[8];
    if (more) { MIX_LOAD_V(c, hd, t3); MIX_LOAD_U(ureg, c, hd, t3); }
    while (more) {
        const bool smp = (c >= 128);
        __syncthreads();
        if (newitem && tid < 128) { const f32x4* p = (const f32x4*)(vstat + (size_t)(128 * c + tid) * 96); float s = 0.f, q = 0.f;
#pragma unroll 8
            for (int k = 0; k < 24; ++k) { const f32x4 v = p[k]; s += v.x + v.z; q += v.y + v.w; }
            const float mean = s * (1.0f / DSGU), var = q * (1.0f / DSGU) - mean * mean; mu[tid] = mean; rsd[tid] = 1.0f / sqrtf(var + LN_EPS); }
#pragma unroll
        for (int i = 0; i < 8; ++i) { const int p = tid + 512 * i, row = p >> 5, c16 = p & 31;
            *(LAS u32x2*)(lds + MIX_V + row * MIX_VS + c16 * 16) = (u32x2){vreg[i].x, vreg[i].y}; *(LAS u32x2*)(lds + MIX_V + row * MIX_VS + c16 * 16 + 8) = (u32x2){vreg[i].z, vreg[i].w}; }
        int nitem = item, nc = c, nhd = hd, ntb = tb, nte = te, nt3 = t3 + 1;
        if (nt3 >= te) { nitem = item + G; mix_decode(nitem, nc, nhd, ntb, nte); nt3 = ntb; }
        const bool nmore = (nitem < MIX_ITEMS);
        if (nmore) { MIX_LOAD_V(nc, nhd, nt3); } else { nc = c; nhd = hd; nt3 = t3; }
        __syncthreads();
        if (newitem) { const int i = tid >> 2, jq = tid & 3, j0 = jq * 32; const int ii = smp ? (i & 31) : i;
          const float* wrow = Wsl + ((size_t)hd * 128 + ii) * 128 + (smp ? 0 : j0);
          const int lim = smp ? ((jq == (i >> 5)) ? ii : -1) : (i - j0);
          float c1p = 0.f, c2p = 0.f;
#pragma unroll 1
          for (int jj = 0; jj < 32; jj += 8) { const f32x4 wa = *(const f32x4*)(wrow + jj), wb = *(const f32x4*)(wrow + jj + 4); const float wv[8] = {wa.x, wa.y, wa.z, wa.w, wb.x, wb.y, wb.z, wb.w}; unsigned hw[8];
#pragma unroll
              for (int e = 0; e < 8; ++e) { const float w = (jj + e <= lim) ? wv[e] : 0.f; c2p += w; hw[e] = f2bf(w * rsd[j0 + jj + e]); c1p += __builtin_bit_cast(float, hw[e] << 16) * mu[j0 + jj + e]; }
              *(LAS u32x4*)(lds + MIX_WP + i * 272 + (j0 + jj) * 2) = (u32x4){hw[0] | (hw[1] << 16), hw[2] | (hw[3] << 16), hw[4] | (hw[5] << 16), hw[6] | (hw[7] << 16)}; }
          c1p += SHX(c1p, 1); c1p += SHX(c1p, 2); c2p += SHX(c2p, 1); c2p += SHX(c2p, 2);
          if (jq == 0) { c1[i] = c1p; c2[i] = c2p; }
          if (tid < 192) *(LAS f32x4*)(lds + MIX_LG + tid * 16) = *(const f32x4*)(lng + 768 * hd + 4 * tid);
          else if (tid < 384) *(LAS f32x4*)(lds + MIX_LB + (tid - 192) * 16) = *(const f32x4*)(lnb + 768 * hd + 4 * (tid - 192));
          else { const int r = tid - 384; *(LAS float*)(lds + MIX_BSV + r * 4) = bs[hd * 128 + (smp ? (r & 31) : r)]; }
          __syncthreads(); }
        {
            const int dcol = 768 * hd + 256 * t3, d0 = dcol + 32 * wave + 8 * fq;
            f32x4 acc[8][2];
#pragma unroll
            for (int mi = 0; mi < 8; ++mi) { acc[mi][0] = (f32x4){0.f, 0.f, 0.f, 0.f}; acc[mi][1] = (f32x4){0.f, 0.f, 0.f, 0.f}; }
#pragma unroll
            for (int ks = 0; ks < 4; ++ks) { bf16x8 Bf[2];
#pragma unroll
                for (int n = 0; n < 2; ++n) { const LAS unsigned char* vb = lds + MIX_V + (32 * wave + pg8::perm32(16 * n + fr)) * 2 + (8 * fq) * MIX_VS; u32x4 t;
#pragma unroll
                    for (int e = 0; e < 4; ++e) { const unsigned lo = *(const LAS unsigned short*)(vb + (32 * ks + 2 * e) * MIX_VS), hi = *(const LAS unsigned short*)(vb + (32 * ks + 2 * e + 1) * MIX_VS); t[e] = lo | (hi << 16); }
                    Bf[n] = __builtin_bit_cast(bf16x8, t); }
#pragma unroll
                for (int mi = 2 * ks; mi < 8; ++mi) { const bf16x8 Af = *(const LAS bf16x8*)(lds + MIX_WP + (16 * mi + fr) * 272 + (32 * ks + 8 * fq) * 2);
                    acc[mi][0] = __builtin_amdgcn_mfma_f32_16x16x32_bf16(Bf[0], Af, acc[mi][0], 0, 0, 0); acc[mi][1] = __builtin_amdgcn_mfma_f32_16x16x32_bf16(Bf[1], Af, acc[mi][1], 0, 0, 0); }
                __builtin_amdgcn_sched_barrier(0); }
            const int dl = (256 * t3 + 32 * wave + 8 * fq) * 4;
            const f32x4 g0 = *(const LAS f32x4*)(lds + MIX_LG + dl), g1 = *(const LAS f32x4*)(lds + MIX_LG + dl + 16), b0 = *(const LAS f32x4*)(lds + MIX_LB + dl), b1 = *(const LAS f32x4*)(lds + MIX_LB + dl + 16);
#pragma unroll
            for (int mi = 0; mi < 8; ++mi) { const int i = 16 * mi + fr; const float c1v = c1[i], c2v = c2[i], bsv = *(const LAS float*)(lds + MIX_BSV + i * 4);
                const u32x4 uw = ureg[mi];
                const f32x4 m0 = g0 * (acc[mi][0] - c1v) + b0 * c2v + bsv, m1 = g1 * (acc[mi][1] - c1v) + b1 * c2v + bsv;
                u32x4 w; w.x = cvt_pk_bf16(bf_lo(uw.x) * m0[0], bf_hi(uw.x) * m0[1]); w.y = cvt_pk_bf16(bf_lo(uw.y) * m0[2], bf_hi(uw.y) * m0[3]);
                w.z = cvt_pk_bf16(bf_lo(uw.z) * m1[0], bf_hi(uw.z) * m1[1]); w.w = cvt_pk_bf16(bf_lo(uw.w) * m1[2], bf_hi(uw.w) * m1[3]);
                if (!(PROBE_MASK && dry)) *(u32x4*)(U + blk_off(128 * c + i, d0, DSGU / 64)) = w;
                ureg[mi] = *(const u32x4*)(U + blk_off(128 * nc + i, 768 * nhd + 256 * nt3 + 32 * wave + 8 * fq, DSGU / 64)); }
        }
        newitem = (nitem != item); more = nmore; item = nitem; c = nc; hd = nhd; tb = ntb; te = nte; t3 = nt3;
    }
    __syncthreads();
}
#undef MIX_LOAD_V
#undef MIX_LOAD_U

constexpr int CONV_RUNS = MP / 64, CONV_ITEMS = CONV_RUNS + 2 * (MS / 32);
constexpr int CONV_P = RS_OFF  , CONV_MR = RS_OFF + 1024  ;
__device__ __forceinline__ f32x2 bfx2(unsigned u) { return (f32x2){bf_lo(u), bf_hi(u)}; }
#define CONV_ROW(S) do { if ((S) < 46) { const f32x2 x_ = bfx2(*(const LAS unsigned*)(lds + ((xoff + (S) * 2048) & 0x1FFFF))); \
        _Pragma("unroll") for (int k = 0; k < 31; ++k) { const int o = (S) - k; if (o >= 0 && o < 16) cv[o] = __builtin_elementwise_fma(w[k], x_, cv[o]); } } } while (0)
#define CONV_R2(S) CONV_ROW((S)); CONV_ROW((S) + 1)
#define CONV_R4(S) CONV_R2((S)); CONV_R2((S) + 2)
#define CONV_R8(S) CONV_R4((S)); CONV_R4((S) + 4)
#define CONV_R16(S) CONV_R8((S)); CONV_R8((S) + 8)
template <int N> __device__ __forceinline__ void xred_step(const float (&v)[N], float (&w)[N / 2], int lane) {
    constexpr int H = N / 2; const bool up = (lane & H) != 0;
#pragma unroll
    for (int k = 0; k < H; ++k) { const float send = up ? v[k] : v[k + H], keep = up ? v[k + H] : v[k]; w[k] = keep + SHX(send, H); }
}
__device__ __forceinline__ void conv_half(const f32x2 (&w)[31], f32x2 bias, f32x2 lg, f32x2 lb, LAS unsigned char* lds, bf16_t* out, int xoff, int tid, int wave, int lane) {
    f32x2 cv[16];
#pragma unroll
    for (int o = 0; o < 16; ++o) cv[o] = bias;
    CONV_R16(0); CONV_R16(16); CONV_R8(32); CONV_R4(40); CONV_R2(44);
    float r32[32], r16[16], r8[8], r4[4], r2[2], r1[1];
#pragma unroll
    for (int o = 0; o < 16; ++o) { r32[2 * o] = cv[o].x + cv[o].y; r32[2 * o + 1] = cv[o].x * cv[o].x + cv[o].y * cv[o].y; }
    xred_step<32>(r32, r16, lane); xred_step<16>(r16, r8, lane); xred_step<8>(r8, r4, lane); xred_step<4>(r4, r2, lane); xred_step<2>(r2, r1, lane);
    const float tot = r1[0] + SHX(r1[0], 32);
    LAS float* P = (LAS float*)(lds + CONV_P); LAS f32x2* MR = (LAS f32x2*)(lds + CONV_MR);
    if (lane < 32) P[wave * 32 + lane] = tot;
    __syncthreads();
    if (tid < 16) { float s = 0.f, q = 0.f;
#pragma unroll
        for (int wv = 0; wv < 8; ++wv) { s += P[wv * 32 + 2 * tid]; q += P[wv * 32 + 2 * tid + 1]; }
        const float mean = s * (1.0f / D), var = q * (1.0f / D) - mean * mean; MR[tid] = (f32x2){mean, 1.0f / sqrtf(var + LN_EPS)}; }
    __syncthreads();
#pragma unroll
    for (int o = 0; o < 16; ++o) { const f32x2 mr = MR[o]; const f32x2 y = (cv[o] - mr.x) * mr.y * lg + lb; const f32x2 sg = sigmoid_pk(y);
        *(unsigned*)(out + (size_t)o * D) = cvt_pk_bf16(y.x * sg.x, y.y * sg.y); }
}
__device__ __forceinline__ void conv_stage(const bf16_t* GL, long g0, int r0, int r1, LAS unsigned char* lds, int wave, int lane) {
    for (int r = r0 + wave; r < r1; r += 8) { const char* g = (const char*)(GL + (g0 + r) * D) + lane * 16;
        __builtin_amdgcn_global_load_lds((const unsigned*)g, (LAS unsigned*)(lds + (r & 63) * 2048), 16, 0, 2);
        __builtin_amdgcn_global_load_lds((const unsigned*)(g + 1024), (LAS unsigned*)(lds + (r & 63) * 2048 + 1024), 16, 0, 2); }
}
#define CONV_SYNC() do { asm volatile("s_waitcnt vmcnt(0) lgkmcnt(0)" ::: "memory"); __syncthreads(); } while (0)
__device__ __forceinline__ void conv_phase(int j, LAS unsigned char* lds, int tid, int, int, int c0, int G) {
    unsigned char* ws = KWS();
    const bf16_t* GL = (const bf16_t*)(ws + WS_GLU); bf16_t* CA = (bf16_t*)(ws + WS_CACT);
    const float* wdw = KIN(I_WDW) + (size_t)j * 31 * D; const float* bdw = KIN(I_BDW) + j * D; const float* lng = KIN(I_CLNG) + j * D; const float* lnb = KIN(I_CLNB) + j * D;
    const float* st = KIN(I_STATE) + (size_t)j * 8 * 30 * D;
    for (int item = c0; item < CONV_ITEMS; item += G) {
        asm volatile("" : "+v"(tid));
        const int ch = 2 * tid, lane = tid & 63, wave = __builtin_amdgcn_readfirstlane(tid >> 6);
        const bool smp = (item >= CONV_RUNS); const int hsel = smp ? ((item - CONV_RUNS) & 1) : 0;
        const int t0 = smp ? MP + 32 * ((item - CONV_RUNS) >> 1) : 64 * item; const bool first = !smp && ((t0 & 4095) == 0);
        __syncthreads();
        if (smp) { conv_stage(GL, (long)t0 - 30, 30, 62, lds, wave, lane);
            const float* sp = st + (size_t)((t0 - MP) >> 5) * 30 * D + ch;
#pragma unroll
            for (int s1 = 0; s1 < 30; s1 += 10) { f32x2 sv[10];
#pragma unroll
                for (int s = 0; s < 10; ++s) sv[s] = *(const f32x2*)(sp + (size_t)(s1 + s) * D);
#pragma unroll
                for (int s = 0; s < 10; ++s) *(LAS unsigned*)(lds + (s1 + s) * 2048 + tid * 4) = cvt_pk_bf16(sv[s].x, sv[s].y);
                asm volatile("" ::: "memory"); }
        } else { conv_stage(GL, (long)t0 - 30, first ? 30 : 0, 46, lds, wave, lane);
            if (first) {
#pragma unroll
                for (int s = 0; s < 30; ++s) *(LAS unsigned*)(lds + s * 2048 + tid * 4) = 0u; } }
        f32x2 w[31];
#pragma unroll
        for (int k = 0; k < 31; ++k) w[k] = *(const f32x2*)(wdw + (size_t)k * D + ch);
        const f32x2 bias = *(const f32x2*)(bdw + ch), lg = *(const f32x2*)(lng + ch), lb = *(const f32x2*)(lnb + ch);
        bf16_t* out = CA + (size_t)t0 * D + ch;
        const int nh = smp ? 1 : 4;
#pragma nounroll
        for (int hh = 0; hh < nh; ++hh) { const int h = smp ? hsel : hh;
            CONV_SYNC();
            if (!smp && hh < 3) conv_stage(GL, (long)t0 - 30, 46 + 16 * hh, 62 + 16 * hh, lds, wave, lane);
            conv_half(w, bias, lg, lb, lds, out + (size_t)h * 16 * D, h * 32768 + tid * 4, tid, wave, lane); }
    }
    __syncthreads();
}
#undef CONV_ROW
#undef CONV_R2
#undef CONV_R4
#undef CONV_R8
#undef CONV_R16
#undef CONV_SYNC

enum { K_P0 = 0, K_GIN, K_GLU, K_MIX, K_CONV, K_RES, K_GU, K_FIN };
__host__ __device__ constexpr int phase_kind(int ph) {
    if (ph == 0) return K_P0; if (ph == NPHASE - 1) return K_FIN;
    const int L = (ph - 1) / 5, s = (ph - 1) % 5; const bool sgu = !(L & 1);
    return s == 0 ? (sgu ? K_GIN : K_GLU) : s == 1 ? (sgu ? K_MIX : K_CONV) : s == 3 ? K_GU : K_RES;
}
template <int PH>
__device__ __forceinline__ void run_phase(LAS unsigned char* lds, LAS float* rstab, int tid, int G, int bx) {
    asm volatile("" : "+v"(tid), "+s"(G), "+s"(bx));
    const int lane = tid & 63, wave = __builtin_amdgcn_readfirstlane(tid >> 6), gw = bx * 8 + wave, NGW = G * 8;
    constexpr int kind = phase_kind(PH);
    constexpr int L = (PH - 1) / 5, s = (PH - 1) % 5, j = L >> 1; constexpr bool sgu = !(L & 1);
    constexpr int reps = (PROBE_MASK && ((PROBE_MASK >> kind) & 1)) ? 2 : 1;
#pragma unroll 1
    for (int rep = 0; rep < reps; ++rep) {
        const bool dry = (rep + 1 < reps); (void)dry;
        if (PROBE_MASK && rep) { __syncthreads(); asm volatile("" : "+v"(tid), "+s"(G), "+s"(bx)); }
        pg8::StaticOrder S;
        if constexpr (kind == K_P0) {
            convert_layer(0, lds, gw, NGW, wave, lane);
            p0_rows(gw, NGW, lane);
        } else if constexpr (kind == K_FIN) {
            final_rows(gw, NGW, lane, dry);
        } else if constexpr (kind == K_GIN) {
            unsigned char* ws = KWS();
            for (int tr = 0; tr < (((PROBE_MASK >> 10) & 1) + 1); ++tr) {
                if (G == 256) thin::t_in3(bx, tid, wave, lane, lds, (const bf16_t*)(ws + WS_XB), (const bf16_t*)(ws + WS_SLOTA + SA_WIN), KIN(I_BIN) + j * DSF, (const float*)(ws + WS_SSQSA), (bf16_t*)(ws + WS_U), (bf16_t*)(ws + WS_V), (float*)(ws + WS_VSTAT), KOUT() + O_SV + (size_t)j * MS * DSGU);
                else for (int t = bx; t < 768; t += G) thin::t_in(t, tid, wave, lane, lds, (const bf16_t*)(ws + WS_XB), (const bf16_t*)(ws + WS_SLOTA + SA_WIN), KIN(I_BIN) + j * DSF, (const float*)(ws + WS_SSQSA), (bf16_t*)(ws + WS_U), (bf16_t*)(ws + WS_V), (float*)(ws + WS_VSTAT), KOUT() + O_SV + (size_t)j * MS * DSGU); }
            __syncthreads();
            pg8::Gemm g{(const bf16_t*)(ws + WS_XB), (const bf16_t*)(ws + WS_SLOTA + SA_WIN), MP, DSF, D}; S.init(MP, DSF, G, bx);
            pg8::EpiIn E{(bf16_t*)(ws + WS_U), (bf16_t*)(ws + WS_V), (float*)(ws + WS_VSTAT), KIN(I_BIN) + j * DSF, (const float*)(ws + WS_SSQA)};
            pg8::gemm_phase<pg8::EpiIn, true, true>(lds, rstab, g, S, E, tid);
        } else if constexpr (kind == K_GLU) {
            unsigned char* ws = KWS(); float* out = KOUT();
            for (int tr = 0; tr < (((PROBE_MASK >> 10) & 1) + 1); ++tr) { for (int t = bx; t < 256; t += G) thin::t_glu(thin::xcd_unit(t, G, 1), tid, wave, lane, lds, (const bf16_t*)(ws + WS_XB), (const bf16_t*)(ws + WS_SLOTB + SB_PW1), KIN(I_BPW1) + j * 2 * D, (const float*)(ws + WS_SSQSA), (bf16_t*)(ws + WS_GLU), out + O_CS + (size_t)j * 8 * 30 * D); }
            __syncthreads();
            pg8::Gemm g{(const bf16_t*)(ws + WS_XB), (const bf16_t*)(ws + WS_SLOTB + SB_PW1), MP, 2 * D, D}; S.init(MP, 2 * D, G, bx);
            pg8::EpiGLU E{(bf16_t*)(ws + WS_GLU), (const float*)(ws + WS_SSQA), KIN(I_BPW1) + j * 2 * D, out + O_CP + (size_t)j * 4 * 30 * D};
            pg8::gemm_phase<pg8::EpiGLU, true, true>(lds, rstab, g, S, E, tid);
        } else if constexpr (kind == K_MIX) {
            sample_v_rows(j, gw, NGW, lane, dry);
            mix_phase(j, lds, tid, wave, lane, bx, G, dry);
        } else if constexpr (kind == K_CONV) {
            conv_phase(j, lds, tid, wave, lane, bx, G);
        } else if constexpr (kind == K_GU) {
            unsigned char* ws = KWS();
            const bf16_t* W = (const bf16_t*)(ws + (sgu ? WS_SLOTA + SA_WGU : WS_SLOTB + SB_WGU));
            if constexpr (L <= 2) { constexpr int NFULL = (M / 256 * (NGU / 256)) % 256;
                if (bx >= NFULL) convert_layer(L + 1, lds, (bx - NFULL) * 8 + wave, (G - NFULL) * 8, wave, lane); }
            pg8::Gemm g{(const bf16_t*)(ws + WS_XB), W, M, NGU, D}; S.init(M, NGU, G, bx);
            pg8::EpiGU E{(bf16_t*)(ws + WS_HID), (const float*)(ws + WS_SSQB), (const float*)(ws + WS_SSQSB)};
            pg8::gemm_phase<pg8::EpiGU, true, true>(lds, rstab, g, S, E, tid);
        } else {
            unsigned char* ws = KWS();
            constexpr int K = (s == 2) ? (sgu ? DSGU : D) : DFF;
            constexpr bool ABLK_A = !(s == 2 && !sgu);
            const bf16_t* A = (const bf16_t*)(ws + ((s == 2) ? (sgu ? WS_U : WS_CACT) : WS_HID));
            const bf16_t* W = (const bf16_t*)(ws + ((s == 2) ? (sgu ? WS_SLOTA + SA_WOUT : WS_SLOTB + SB_PW2) : (sgu ? WS_SLOTA + SA_WDN : WS_SLOTB + SB_WDN)));
            const float* bias = (s == 2) ? (sgu ? KIN(I_BOUT) + j * D : KIN(I_BPW2) + j * D) : nullptr;
            float* ssqo = (float*)(ws + ((s == 2) ? WS_SSQB : WS_SSQA)); float* ssqso = (float*)(ws + ((s == 2) ? WS_SSQSB : WS_SSQSA));
            const float* bp = nullptr; const float* bsp = nullptr;
            if constexpr (L == 0 && s == 2) { bp = KIN(I_XP); bsp = KIN(I_XS); }
            for (int tr = 0; tr < (((PROBE_MASK >> 10) & 1) + 1); ++tr) { for (int t = bx; t < 256; t += G) thin::t_res(thin::xcd_unit(t, G, 1), tid, wave, lane, lds, A, K, W, bias, bsp, (bf16_t*)(ws + WS_XB), ssqso, dry || (PROBE_MASK && tr == 0 && ((PROBE_MASK >> 10) & 1)), ABLK_A); }
            __syncthreads();
            pg8::Gemm g{A, W, MP, D, K};
            pg8::EpiRes E{bp, (bf16_t*)(ws + WS_XB), ssqo, bias, dry};
            S.init(MP, D, G, bx);
            pg8::gemm_phase<pg8::EpiRes, true, true, ABLK_A>(lds, rstab, g, S, E, tid);
        }
    }
}

__global__ void __launch_bounds__(512, 2) trunk_fwd(Args args) {
    extern __shared__ __attribute__((aligned(16))) unsigned char lds_raw[];
    LAS unsigned char* lds = (LAS unsigned char*)lds_raw;
    const int tid0 = threadIdx.x;
    const int G0 = gridDim.x, bx0 = blockIdx.x;
    volatile LAS unsigned* MISC = (volatile LAS unsigned*)(lds + MISC_OFF);
    LAS float* rstab = (LAS float*)(lds + RS_OFF);
    for (int u = tid0; u < (LDS_BYTES - LDSCTL_OFF) / 4; u += 512) ((LAS unsigned*)(lds + LDSCTL_OFF))[u] = 0u;
    __syncthreads();
    const int ph_lo = args.ph_lo, ph_hi = args.ph_hi;
    XcdBarrier bar; bar.bar = nullptr; bar.x = 0; bar.st = nullptr;
    if (ph_hi - ph_lo > 1) bar = xcd_barrier_post((unsigned*)(KWS() + WS_CTL) + CW_BAR, MISC + 8);
    unsigned long long dsum = 0ull;
#define PHASE(k) if (ph_lo <= (k) && (k) < ph_hi) { const unsigned long long t0_ = (PROBE_T >> (k)) & 1u ? __builtin_amdgcn_s_memrealtime() : 0ull; run_phase<k>(lds, rstab, tid0, G0, bx0); \
        if (((PROBE_T >> (k)) & 1u) && (PROBE_T >> 31)) dsum += __builtin_amdgcn_s_memrealtime() - t0_; \
        if ((k) + 1 < ph_hi) { bar.bar = (unsigned*)(KWS() + WS_CTL) + CW_BAR; xcd_barrier(bar); if ((PROBE_MASK >> 9) & 1) xcd_barrier(bar); } \
        if (((PROBE_T >> (k)) & 1u) && !(PROBE_T >> 31)) dsum += __builtin_amdgcn_s_memrealtime() - t0_; }
    PHASE(0) PHASE(1) PHASE(2) PHASE(3) PHASE(4) PHASE(5) PHASE(6) PHASE(7) PHASE(8) PHASE(9) PHASE(10)
    PHASE(11) PHASE(12) PHASE(13) PHASE(14) PHASE(15) PHASE(16) PHASE(17) PHASE(18) PHASE(19) PHASE(20) PHASE(21)
#undef PHASE
    if (PROBE_T && bx0 == 0 && tid0 == 0) { const unsigned long long t = __builtin_amdgcn_s_memrealtime(); while (__builtin_amdgcn_s_memrealtime() - t < 8ull * dsum) __builtin_amdgcn_s_sleep(16); }
}

extern "C" void kernel_launch(void* const* d_in, const int* in_sizes, int n_in, void* d_out, int out_size, void* d_ws, size_t ws_size, hipStream_t stream) {
    static int grid = 0;
    constexpr int NL = MK_N_LAUNCHES;
    if (grid == 0) {
        if (n_in != 25 || in_sizes[0] != MP * D || (size_t)out_size != O_END || ws_size < WS_END) {
            fprintf(stderr, "kernel_launch: unexpected shapes: n_in %d in0 %d out %d ws %zu (need %zu)\n", n_in, n_in > 0 ? in_sizes[0] : -1, out_size, ws_size, (size_t)WS_END); grid = -1; return; }
        int dev = 0, cus = 0, per_cu = 0;
        if (hipGetDevice(&dev) != hipSuccess || hipDeviceGetAttribute(&cus, hipDeviceAttributeMultiprocessorCount, dev) != hipSuccess) { grid = -1; return; }
        if (hipFuncSetAttribute((const void*)trunk_fwd, hipFuncAttributeMaxDynamicSharedMemorySize, LDS_BYTES) != hipSuccess) { fprintf(stderr, "kernel_launch: hipFuncSetAttribute failed\n"); grid = -1; return; }
        if (hipOccupancyMaxActiveBlocksPerMultiprocessor(&per_cu, (const void*)trunk_fwd, 512, LDS_BYTES) != hipSuccess || per_cu < 1) fprintf(stderr, "kernel_launch: occupancy query reports %d workgroups per CU\n", per_cu);
        (void)hipGetLastError();
        grid = cus;
    }
    if (grid < 0) return;
    if (hipMemsetAsync((char*)d_ws + WS_CTL + (size_t)CW_BAR * 4, 0, (size_t)XCD_BAR_WORDS * 4, stream) != hipSuccess)     { fprintf(stderr, "kernel_launch: memset failed\n"); return; }
    Args a{};
    for (int i = 0; i < 25; ++i) a.in[i] = (const float*)d_in[i];
    a.out = (float*)d_out; a.ws = (unsigned char*)d_ws;
    if (NL == 1) { a.ph_lo = 0; a.ph_hi = NPHASE; hipLaunchKernelGGL(trunk_fwd, dim3(grid), dim3(512), LDS_BYTES, stream, a); }
    else for (int ph = 0; ph < NPHASE; ++ph) { a.ph_lo = ph; a.ph_hi = ph + 1; hipLaunchKernelGGL(trunk_fwd, dim3(grid), dim3(512), LDS_BYTES, stream, a); }
    const hipError_t le = hipPeekAtLastError();
    if (le != hipSuccess) fprintf(stderr, "kernel_launch: launch failed: %s\n", hipGetErrorName(le));
}
```

```cpp
#include <hip/hip_runtime.h>
#include <cstdio>
#include <cstdint>

#ifndef MK_N_LAUNCHES
#define MK_N_LAUNCHES 1
#endif

#ifndef PROBE_T
#define PROBE_T 0u
#endif
#ifndef PROBE_MASK
#define PROBE_MASK 0
#endif
#define LAS __attribute__((address_space(3)))
#define GAS __attribute__((address_space(1)))
typedef unsigned short bf16_t;
typedef short bf16x8 __attribute__((ext_vector_type(8)));
typedef float f32x4 __attribute__((ext_vector_type(4)));
typedef float f32x2 __attribute__((ext_vector_type(2)));
typedef unsigned u32x4 __attribute__((ext_vector_type(4)));
typedef unsigned u32x2 __attribute__((ext_vector_type(2)));

constexpr int D = 1024, MP = 16384, MS = 256, M = MP + MS, DSGU = 3072, DSF = 6144, DFF = 2816, NGU = 2 * DFF;
constexpr int NPHASE = 22;
constexpr float RMS_EPS = 1e-6f, LN_EPS = 1e-5f;

constexpr size_t O_Y = 0, O_CP = (size_t)M * D, O_CS = O_CP + 2 * 4 * 30 * 1024, O_SV = O_CS + 2 * 8 * 30 * 1024, O_END = O_SV + 2 * 8 * 32 * 3072;

constexpr size_t MiB = 1u << 20;
constexpr size_t WS_CTL = 0, CTL_ZERO_BYTES = 1 * MiB;
constexpr size_t WS_SSQA = 1 * MiB, WS_SSQB = WS_SSQA + 1064960, WS_VSTAT = WS_SSQB + 1064960;
constexpr size_t WS_SSQSA = WS_VSTAT + 6389760, WS_SSQSB = WS_SSQSA + 32768;
constexpr size_t WS_SLOTA = 9 * MiB + 256 * 1024, WS_SLOTB = WS_SLOTA + 36175872, WS_XB = WS_SLOTB + 23592960, WS_U = WS_XB + 34078720, WS_V = WS_U + 102236160, WS_END = WS_V + 102236160;
constexpr size_t WS_HID = WS_U, WS_GLU = WS_U, WS_CACT = WS_U + 33 * MiB;
static_assert((size_t)M * 96 * 4 == 6389760 && WS_SSQSB + 32768 <= WS_SLOTA, "ws map");
static_assert((size_t)M * 16 * 4 <= 1064960 && (size_t)M * D * 2 == 34078720 && (size_t)M * DSGU * 2 == 102236160, "ws map");
static_assert(WS_END <= 310173696, "ws map: must fit sum(inputs) bytes");
static_assert(WS_HID + (size_t)M * DFF * 2 <= WS_V && WS_GLU + (size_t)M * D * 2 <= WS_CACT, "ws map");
constexpr size_t SA_WIN = 0, SA_WOUT = 12582912, SA_WGU = 18874368, SA_WDN = 30408704;
constexpr size_t SB_PW1 = 0, SB_PW2 = 4194304, SB_WGU = 6291456, SB_WDN = 17825792;

constexpr int CW_BAR = 4096;

constexpr int RING_BYTES = 131072, RS_OFF = RING_BYTES  , LDSCTL_OFF = RING_BYTES + 2048, MISC_OFF = LDSCTL_OFF + 320, LDS_BYTES = 147456;

__device__ __forceinline__ unsigned cvt_pk_bf16(float lo, float hi) { unsigned r; asm volatile("v_cvt_pk_bf16_f32 %0, %1, %2" : "=v"(r) : "v"(lo), "v"(hi)); return r; }
__device__ __forceinline__ unsigned f2bf(float f) { unsigned u = __builtin_bit_cast(unsigned, f); return (u + 0x7fffu + ((u >> 16) & 1u)) >> 16; }
__device__ __forceinline__ unsigned pk2(float lo, float hi) { return f2bf(lo) | (f2bf(hi) << 16); }
__device__ __forceinline__ float bf_lo(unsigned w) { return __builtin_bit_cast(float, w << 16); }
__device__ __forceinline__ float bf_hi(unsigned w) { return __builtin_bit_cast(float, w & 0xffff0000u); }
__device__ __forceinline__ float gelu_tanh(float x) {
    const float y = x * (1.0f + 0.044715f * x * x);
    return x * __builtin_amdgcn_rcpf(1.0f + __builtin_amdgcn_exp2f(-2.302208198f * y));
}
__device__ __forceinline__ f32x2 gelu_pk(f32x2 x) {
    const f32x2 t = x * x, u = t * (-0.10294324f) + (-2.302208198f), m = x * u;
    f32x2 e; e.x = __builtin_amdgcn_exp2f(m.x); e.y = __builtin_amdgcn_exp2f(m.y);
    const f32x2 d = e + 1.0f; f32x2 r; r.x = __builtin_amdgcn_rcpf(d.x); r.y = __builtin_amdgcn_rcpf(d.y);
    return x * r;
}
__device__ __forceinline__ f32x2 sigmoid_pk(f32x2 x) {
    const f32x2 m = x * (-1.4426950409f); f32x2 e; e.x = __builtin_amdgcn_exp2f(m.x); e.y = __builtin_amdgcn_exp2f(m.y);
    const f32x2 d = e + 1.0f; f32x2 r; r.x = __builtin_amdgcn_rcpf(d.x); r.y = __builtin_amdgcn_rcpf(d.y); return r;
}
__device__ __forceinline__ f32x4 gelu4(f32x4 v) { const f32x2 a = gelu_pk((f32x2){v[0], v[1]}), b = gelu_pk((f32x2){v[2], v[3]}); return (f32x4){a.x, a.y, b.x, b.y}; }
__device__ __forceinline__ f32x4 sigmoid4(f32x4 v) { const f32x2 a = sigmoid_pk((f32x2){v[0], v[1]}), b = sigmoid_pk((f32x2){v[2], v[3]}); return (f32x4){a.x, a.y, b.x, b.y}; }
__device__ __forceinline__ float sigmoid_f(float x) { return __builtin_amdgcn_rcpf(1.0f + __builtin_amdgcn_exp2f(-1.4426950409f * x)); }
#define SHX(v, m) __builtin_bit_cast(float, __builtin_amdgcn_ds_bpermute(((lane) ^ (m)) << 2, __builtin_bit_cast(int, (float)(v))))
__device__ __forceinline__ float wave_sum(float v, int lane) {
#pragma unroll
    for (int o = 1; o < 64; o <<= 1) v += SHX(v, o);
    return v;
}
__device__ __forceinline__ size_t blk_off(int row, int col, int KT) { return ((((size_t)(row >> 8) * KT + (col >> 6)) * 256 + (row & 255)) * 64 + (col & 63)); }
#define LDS_WAIT() asm volatile("s_waitcnt lgkmcnt(0)" ::: "memory")
#define VM_WAIT() asm volatile("s_waitcnt vmcnt(0)" ::: "memory")

__device__ __forceinline__ unsigned long long karg_u64(int idx) {
    const unsigned long long k = (unsigned long long)__builtin_amdgcn_kernarg_segment_ptr(); unsigned long long v;
    asm volatile("s_load_dwordx2 %0, %1, %2\n\ts_waitcnt lgkmcnt(0)" : "=s"(v) : "s"(k), "i"(idx * 8)); return v;
}
#define KIN(idx) ((const float*)(const GAS float*)karg_u64(idx))
#define KOUT() ((float*)(GAS float*)karg_u64(25))
#define KWS() ((unsigned char*)(GAS unsigned char*)karg_u64(26))

namespace pg8 {
constexpr int BM = 256, BK = 64, HALF = 128, HTB = HALF * BK * 2, STAGE_BYTES = 8 * HTB, NXCD = 8, WGM = 8;
__host__ __device__ __forceinline__ int lds_byte(int r, int c) { const int ch = c >> 3; return (r >> 3) * 1024 + (ch >> 1) * 256 + (r & 7) * 32 + (ch & 1) * 16 + (c & 7) * 2; }
__host__ __device__ __forceinline__ void stage_rc(int b, int& R, int& C) { const int sb = b % 1024; R = (b / 1024) * 8 + (sb % 256) / 32; C = (2 * (sb / 256) + (sb % 32) / 16) * 8 + (sb % 16) / 2; }
__host__ __device__ __forceinline__ int perm32(int rho) { const int n = rho >> 4, i = rho & 15; return 8 * (i >> 2) + 4 * n + (i & 3); }

struct Unit { int pm, pn; };
struct Gemm { const bf16_t* A; const bf16_t* Bt; int M, N, K; };

struct StaticOrder {
    int nM, nN, nwg, G, c, nextra;
    __device__ void init(int M_, int N_, int G_, int c_) { nM = M_ / BM; nN = N_ / BM; nextra = 0; if (nM > 64) { nextra = (nM - 64) * nN; nM = 64; } nwg = nM * nN; G = G_; c = c_; }
    __device__ bool next(int i, Unit& u) const {
        const long L = (long)i * G + c; if (L >= nwg) { if (L >= nwg + nextra) return false; u.pm = 64 + (int)(L - nwg) / nN; u.pn = (int)(L - nwg) % nN; return true; }
        int wgid = (int)L; { const int q = nwg / NXCD, r = nwg % NXCD, xcd = wgid % NXCD, off = wgid / NXCD; wgid = (xcd < r ? xcd * (q + 1) : r * (q + 1) + (xcd - r) * q) + off; }
        const int nig = WGM * nN, gid = wgid / nig, fm = gid * WGM, gsz = (nM - fm) < WGM ? (nM - fm) : WGM;
        u.pm = fm + ((wgid % nig) % gsz); u.pn = (wgid % nig) / gsz; return true;
    }
};

template <class Epi, bool ALIGN_EPI, bool SP2, bool ABLK = false>
__device__ __forceinline__ void gemm_phase(LAS unsigned char* lds, LAS float* rstab, const Gemm g, const StaticOrder& S, const Epi& E, const int tid) {
    const int wid = __builtin_amdgcn_readfirstlane(tid >> 6), lane = tid & 63, wr = wid >> 2, wc = wid & 3, fr = lane & 15, fq = lane >> 4;
    const int K = g.K, nt = K / BK;
    unsigned voffA[2], voffB[2];
#pragma unroll
    for (int i = 0; i < 2; ++i) { int R, C; stage_rc(tid * 16 + i * 8192, R, C); const int Rb = (R & ~31) + perm32(R & 31);
        voffA[i] = (unsigned)(R * (ABLK ? BK : K) + C) * 2u; voffB[i] = (unsigned)(Rb * K + C) * 2u; }
    const size_t kstep = (size_t)(BK * 2);
    const size_t hstep = (size_t)HALF * K * 2;
    const size_t tstep = 2 * hstep;
    const size_t kstepA = ABLK ? (size_t)BM * BK * 2 : kstep, hstepA = ABLK ? (size_t)HALF * BK * 2 : hstep, tstepA = ABLK ? (size_t)(K / BK) * BM * BK * 2 : tstep;
    const unsigned ldsw = (unsigned)wid * 1024u;
    const int aoff = lds_byte(wr * 64 + fr, fq * 8), boff = lds_byte(wc * 32 + fr, fq * 8);
#define PG8_SA(b, h) (((b) * 2 + (h)) * HTB)
#define PG8_SB(b, h) ((4 + (b) * 2 + (h)) * HTB)
#define PG8_STAGE(bufoff, gbase, voff) do { _Pragma("unroll") for (int _i = 0; _i < 2; ++_i) \
        __builtin_amdgcn_global_load_lds((const unsigned*)((const char*)(gbase) + (voff)[_i]), (LAS unsigned*)(lds + (bufoff) + ldsw + _i * 8192), 16, 0, 0); } while (0)
#define PG8_LDA(dst, b, h) do { _Pragma("unroll") for (int m = 0; m < 4; ++m) _Pragma("unroll") for (int k = 0; k < 2; ++k) dst[m][k] = *(const LAS bf16x8*)(lds + PG8_SA(b, h) + aoff + m * 2048 + k * 512); } while (0)
#define PG8_LDB(dst, b, h) do { _Pragma("unroll") for (int n = 0; n < 2; ++n) _Pragma("unroll") for (int k = 0; k < 2; ++k) dst[n][k] = *(const LAS bf16x8*)(lds + PG8_SB(b, h) + boff + n * 2048 + k * 512); } while (0)
#define PG8_MMA(ai, bj, At, Bt) do { __builtin_amdgcn_s_setprio(1); _Pragma("unroll") for (int m = 0; m < 4; ++m) _Pragma("unroll") for (int n = 0; n < 2; ++n) _Pragma("unroll") for (int k = 0; k < 2; ++k) \
        acc[ai][bj][m][n] = __builtin_amdgcn_mfma_f32_16x16x32_bf16(Bt[n][k], At[m][k], acc[ai][bj][m][n], 0, 0, 0); __builtin_amdgcn_s_setprio(0); } while (0)
#define PG8_WAIT_V(n) asm volatile("s_waitcnt vmcnt(" #n ")" ::: "memory")
#define PG8_WAIT_L(n) asm volatile("s_waitcnt lgkmcnt(" #n ")" ::: "memory")
#define PG8_BAR __builtin_amdgcn_s_barrier()
#define PG8_SCHED __builtin_amdgcn_sched_barrier(0)
#define PG8_PTRS(u, pa, pb) do { pa = (const char*)g.A + (size_t)(u).pm * tstepA; pb = (const char*)g.Bt + (size_t)(u).pn * tstep; } while (0)
    Unit cur, nxt; int ui = 0;
    if (!S.next(0, cur)) return;
    f32x4 acc[2][2][4][2];
#pragma unroll
    for (int a = 0; a < 2; ++a)
#pragma unroll
        for (int b = 0; b < 2; ++b)
#pragma unroll
            for (int m = 0; m < 4; ++m)
#pragma unroll
                for (int n = 0; n < 2; ++n) acc[a][b][m][n] = (f32x4){0.f, 0.f, 0.f, 0.f};
    bf16x8 At[4][2], B0[2][2], B1[2][2];
    const char* cA; const char* cB; PG8_PTRS(cur, cA, cB);
    if (Epi::NEEDS_RS) { if (tid < 256) E.prep(cur, rstab, tid); }
    if constexpr (SP2) {
        PG8_STAGE(PG8_SB(0, 0), cB, voffB); PG8_STAGE(PG8_SB(0, 1), cB + hstep, voffB); PG8_STAGE(PG8_SA(0, 0), cA, voffA); PG8_STAGE(PG8_SA(0, 1), cA + hstepA, voffA);
        if (wr == 1) PG8_BAR;
        PG8_WAIT_V(2); PG8_BAR;
        PG8_STAGE(PG8_SB(1, 0), cB + kstep, voffB); PG8_STAGE(PG8_SA(1, 0), cA + kstepA, voffA); PG8_STAGE(PG8_SB(1, 1), cB + hstep + kstep, voffB);
        PG8_WAIT_V(6); PG8_BAR;
    } else {
        PG8_STAGE(PG8_SB(0, 0), cB, voffB); PG8_STAGE(PG8_SA(0, 0), cA, voffA); PG8_STAGE(PG8_SB(0, 1), cB + hstep, voffB); PG8_STAGE(PG8_SA(0, 1), cA + hstepA, voffA);
        if (wr == 1) PG8_BAR;
        PG8_WAIT_V(4); PG8_BAR;
        PG8_STAGE(PG8_SB(1, 0), cB + kstep, voffB); PG8_STAGE(PG8_SA(1, 0), cA + kstepA, voffA); PG8_STAGE(PG8_SB(1, 1), cB + hstep + kstep, voffB);
        PG8_WAIT_V(6); PG8_BAR;
    }
    for (;;) {
        const bool has_next = S.next(ui + 1, nxt);
        const char* nA = cA; const char* nB = cB; if (has_next) PG8_PTRS(nxt, nA, nB);
        for (int t = 0; t < nt; t += 2) {
            const bool last = (t == nt - 2);
            const char* a1 = cA + (size_t)(t + 1) * kstepA;
            const char* a2 = last ? nA : cA + (size_t)(t + 2) * kstepA; const char* b2 = last ? nB : cB + (size_t)(t + 2) * kstep;
            const char* a3 = a2 + kstepA; const char* b3 = b2 + kstep;
            if constexpr (SP2) {
            PG8_LDB(B0, 0, 0); PG8_LDB(B1, 0, 1); PG8_SCHED; PG8_LDA(At, 0, 0); PG8_STAGE(PG8_SA(1, 1), a1 + hstepA, voffA);
            PG8_WAIT_V(8); PG8_WAIT_L(0); PG8_BAR; PG8_MMA(0, 0, At, B0); PG8_MMA(0, 1, At, B1); PG8_BAR; PG8_SCHED;
            PG8_LDA(At, 0, 1); PG8_STAGE(PG8_SB(0, 0), b2, voffB); PG8_STAGE(PG8_SB(0, 1), b2 + hstep, voffB); PG8_STAGE(PG8_SA(0, 0), a2, voffA);
            PG8_WAIT_V(8); PG8_WAIT_L(0); PG8_BAR; PG8_MMA(1, 0, At, B0); PG8_MMA(1, 1, At, B1); PG8_BAR; PG8_SCHED;
            PG8_LDB(B0, 1, 0); PG8_LDB(B1, 1, 1); PG8_SCHED; PG8_LDA(At, 1, 0); PG8_STAGE(PG8_SA(0, 1), a2 + hstepA, voffA);
            PG8_WAIT_V(8); PG8_WAIT_L(0); PG8_BAR; PG8_MMA(0, 0, At, B0); PG8_MMA(0, 1, At, B1); PG8_BAR; PG8_SCHED;
            PG8_LDA(At, 1, 1); PG8_STAGE(PG8_SB(1, 0), b3, voffB); PG8_STAGE(PG8_SB(1, 1), b3 + hstep, voffB); PG8_STAGE(PG8_SA(1, 0), a3, voffA);
            PG8_WAIT_V(8); PG8_WAIT_L(0); PG8_BAR; PG8_MMA(1, 0, At, B0); PG8_MMA(1, 1, At, B1); PG8_BAR; PG8_SCHED;
            } else {
            PG8_LDB(B0, 0, 0); PG8_SCHED; PG8_LDA(At, 0, 0); PG8_STAGE(PG8_SA(1, 1), a1 + hstepA, voffA);
            PG8_WAIT_L(8); PG8_BAR; PG8_WAIT_L(0); PG8_MMA(0, 0, At, B0); PG8_BAR; PG8_SCHED;
            PG8_LDB(B1, 0, 1); PG8_STAGE(PG8_SB(0, 0), b2, voffB);
            PG8_BAR; PG8_WAIT_L(0); PG8_MMA(0, 1, At, B1); PG8_BAR;
            PG8_LDA(At, 0, 1); PG8_STAGE(PG8_SA(0, 0), a2, voffA);
            PG8_BAR; PG8_WAIT_L(0); PG8_MMA(1, 0, At, B0); PG8_BAR; PG8_SCHED;
            PG8_STAGE(PG8_SB(0, 1), b2 + hstep, voffB);
            PG8_WAIT_V(6); PG8_BAR; PG8_MMA(1, 1, At, B1); PG8_BAR;
            PG8_LDB(B0, 1, 0); PG8_SCHED; PG8_LDA(At, 1, 0); PG8_STAGE(PG8_SA(0, 1), a2 + hstepA, voffA);
            PG8_WAIT_L(8); PG8_BAR; PG8_WAIT_L(0); PG8_MMA(0, 0, At, B0); PG8_BAR; PG8_SCHED;
            PG8_LDB(B1, 1, 1); PG8_STAGE(PG8_SB(1, 0), b3, voffB);
            PG8_BAR; PG8_WAIT_L(0); PG8_MMA(0, 1, At, B1); PG8_BAR;
            PG8_LDA(At, 1, 1); PG8_STAGE(PG8_SA(1, 0), a3, voffA);
            PG8_BAR; PG8_WAIT_L(0); PG8_MMA(1, 0, At, B0); PG8_BAR; PG8_SCHED;
            PG8_STAGE(PG8_SB(1, 1), b3 + hstep, voffB);
            PG8_WAIT_V(6); PG8_BAR; PG8_MMA(1, 1, At, B1); PG8_BAR;
            }
        }
        if constexpr (ALIGN_EPI) { if (wr == 0) PG8_BAR; }
        E(acc, cur, wr, wc, fr, fq, rstab + (ui & 1) * 256);
        if (!has_next) break;
        if (Epi::NEEDS_RS) { if (tid < 256) E.prep(nxt, rstab + ((ui + 1) & 1) * 256, tid); }
#pragma unroll
        for (int a = 0; a < 2; ++a)
#pragma unroll
            for (int b = 0; b < 2; ++b)
#pragma unroll
                for (int m = 0; m < 4; ++m)
#pragma unroll
                    for (int n = 0; n < 2; ++n) acc[a][b][m][n] = (f32x4){0.f, 0.f, 0.f, 0.f};
        cur = nxt; cA = nA; cB = nB; ++ui;
        if constexpr (ALIGN_EPI) { if (wr == 1) PG8_BAR; }
    }
    PG8_WAIT_V(0);
    if constexpr (!ALIGN_EPI) { if (wr == 0) PG8_BAR; }
    PG8_BAR;
#undef PG8_SA
#undef PG8_SB
#undef PG8_STAGE
#undef PG8_LDA
#undef PG8_LDB
#undef PG8_MMA
#undef PG8_WAIT_V
#undef PG8_WAIT_L
#undef PG8_BAR
#undef PG8_SCHED
#undef PG8_PTRS
}

__device__ __forceinline__ void rs_prep(const float* ssq, const Unit& u, LAS float* tab, int tid) {
    const f32x4* p = (const f32x4*)(ssq + (size_t)(u.pm * BM + tid) * 16);
    const f32x4 a = p[0], b = p[1], c = p[2], d = p[3];
    const f32x4 s4 = (a + b) + (c + d); const float s = (s4.x + s4.y) + (s4.z + s4.w);
    VM_WAIT();
    tab[tid] = 1.0f / sqrtf(s * (1.0f / D) + RMS_EPS);
}

struct EpiIn {
    static constexpr bool NEEDS_RS = true;
    bf16_t* U; bf16_t* V; float* vstat; const float* bias; const float* ssq;
    __device__ __forceinline__ void prep(const Unit& u, LAS float* tab, int tid) const { rs_prep(ssq, u, tab, tid); }
    __device__ __forceinline__ void operator()(f32x4 (&acc)[2][2][4][2], const Unit& u, int wr, int wc, int fr, int fq, const LAS float* tab) const { const int lane = fq * 16 + fr; (void)lane;
        const bool isv = (u.pn >= 12); const int pv = u.pn - 12;
        const int row0 = u.pm * BM + wr * 64 + fr, col0 = (isv ? pv : u.pn) * BM + wc * 32 + 8 * fq, bcol0 = u.pn * BM + wc * 32 + 8 * fq;
        bf16_t* O = isv ? V : U;
        f32x4 bv[2][2];
#pragma unroll
        for (int bj = 0; bj < 2; ++bj)
#pragma unroll
            for (int n = 0; n < 2; ++n) bv[bj][n] = *(const f32x4*)(bias + bcol0 + bj * HALF + 4 * n);
#pragma unroll
        for (int ai = 0; ai < 2; ++ai)
#pragma unroll
            for (int m = 0; m < 4; ++m) { const int rl = ai * HALF + wr * 64 + m * 16 + fr; const float rs = tab[rl];
                bf16_t* rowp = isv ? O + (size_t)(row0 + ai * HALF + m * 16) * DSGU + col0 : O + blk_off(row0 + ai * HALF + m * 16, col0, DSGU / 64);
                float sa = 0.f, sb = 0.f;
#pragma unroll
                for (int bj = 0; bj < 2; ++bj) { f32x4 v0 = acc[ai][bj][m][0] * rs + bv[bj][0], v1 = acc[ai][bj][m][1] * rs + bv[bj][1];
                    v0 = gelu4(v0); v1 = gelu4(v1);
                    u32x4 w; w.x = cvt_pk_bf16(v0[0], v0[1]); w.y = cvt_pk_bf16(v0[2], v0[3]); w.z = cvt_pk_bf16(v1[0], v1[1]); w.w = cvt_pk_bf16(v1[2], v1[3]);
                    *(u32x4*)(rowp + (isv ? bj * HALF : bj * 2 * 256 * 64)) = w;
                    if (isv) { sa += (v0[0] + v0[1]) + (v0[2] + v0[3]) + (v1[0] + v1[1]) + (v1[2] + v1[3]);
                        sb += (v0[0] * v0[0] + v0[1] * v0[1]) + (v0[2] * v0[2] + v0[3] * v0[3]) + (v1[0] * v1[0] + v1[1] * v1[1]) + (v1[2] * v1[2] + v1[3] * v1[3]);
 } }
                if (isv) { sa += SHX(sa, 16); sa += SHX(sa, 32); sb += SHX(sb, 16); sb += SHX(sb, 32);
                    if (fq == 0) *(f32x2*)(vstat + (size_t)(row0 + ai * HALF + m * 16) * 96 + (pv * 4 + wc) * 2) = (f32x2){sa, sb}; }
            }
    }
};

struct EpiRes {
    static constexpr bool NEEDS_RS = false;
    const float* base_f; bf16_t* XB; float* ssq; const float* bias; bool dry;
    __device__ __forceinline__ void prep(const Unit&, LAS float*, int) const {}
    __device__ __forceinline__ void operator()(f32x4 (&acc)[2][2][4][2], const Unit& u, int wr, int wc, int fr, int fq, const LAS float*) const { const int lane = fq * 16 + fr; (void)lane;
        const int row0 = u.pm * BM + wr * 64 + fr, col0 = u.pn * BM + wc * 32 + 8 * fq;
        f32x4 bv[2][2];
#pragma unroll
        for (int bj = 0; bj < 2; ++bj)
#pragma unroll
            for (int n = 0; n < 2; ++n) bv[bj][n] = bias ? *(const f32x4*)(bias + col0 + bj * HALF + 4 * n) : (f32x4){0.f, 0.f, 0.f, 0.f};
#pragma unroll
        for (int ai = 0; ai < 2; ++ai)
#pragma unroll
            for (int m = 0; m < 4; ++m) { const int rl = ai * HALF + m * 16; const size_t ro = (size_t)(row0 + rl) * D + col0; float qs = 0.f;
#pragma unroll
                for (int bj = 0; bj < 2; ++bj) { f32x4 b0, b1;
                    if (base_f) { b0 = *(const f32x4*)(base_f + ro + bj * HALF); b1 = *(const f32x4*)(base_f + ro + bj * HALF + 4); }
                    else { const u32x4 t = *(const u32x4*)(XB + ro + bj * HALF); b0 = (f32x4){bf_lo(t.x), bf_hi(t.x), bf_lo(t.y), bf_hi(t.y)}; b1 = (f32x4){bf_lo(t.z), bf_hi(t.z), bf_lo(t.w), bf_hi(t.w)}; }
                    const f32x4 x0 = b0 + acc[ai][bj][m][0] + bv[bj][0], x1 = b1 + acc[ai][bj][m][1] + bv[bj][1];
                    u32x4 w; w.x = cvt_pk_bf16(x0[0], x0[1]); w.y = cvt_pk_bf16(x0[2], x0[3]); w.z = cvt_pk_bf16(x1[0], x1[1]); w.w = cvt_pk_bf16(x1[2], x1[3]);
                    if (!(PROBE_MASK && dry)) *(u32x4*)(XB + ro + bj * HALF) = w;
                    qs += (x0[0] * x0[0] + x0[1] * x0[1]) + (x0[2] * x0[2] + x0[3] * x0[3]) + (x1[0] * x1[0] + x1[1] * x1[1]) + (x1[2] * x1[2] + x1[3] * x1[3]); }
                qs += SHX(qs, 16); qs += SHX(qs, 32);
                if (fq == 0) ssq[(size_t)(row0 + rl) * 16 + u.pn * 4 + wc] = qs;
                asm volatile("" ::: "memory"); }
    }
};

struct EpiGU {
    static constexpr bool NEEDS_RS = true;
    bf16_t* H; const float* ssq; const float* ssqs;
    __device__ __forceinline__ void prep(const Unit& u, LAS float* tab, int tid) const {
        if (u.pm < MP / BM) rs_prep(ssq, u, tab, tid);
        else { const f32x4* p = (const f32x4*)(ssqs + (size_t)tid * 32); f32x4 a = p[0];
#pragma unroll
            for (int k = 1; k < 8; ++k) a += p[k];
            VM_WAIT(); tab[tid] = 1.0f / sqrtf(((a.x + a.y) + (a.z + a.w)) * (1.0f / D) + RMS_EPS); } }
    __device__ __forceinline__ void operator()(f32x4 (&acc)[2][2][4][2], const Unit& u, int wr, int wc, int fr, int fq, const LAS float* tab) const { const int lane = fq * 16 + fr; (void)lane;
        const int row0 = u.pm * BM + wr * 64 + fr, col0 = u.pn * HALF + wc * 32 + 8 * fq;
#pragma unroll
        for (int ai = 0; ai < 2; ++ai)
#pragma unroll
            for (int m = 0; m < 4; ++m) { const float rs = tab[ai * HALF + wr * 64 + m * 16 + fr];
                f32x4 h[2];
#pragma unroll
                for (int n = 0; n < 2; ++n) { const f32x4 gg = acc[ai][0][m][n] * rs, uu = acc[ai][1][m][n] * rs; h[n] = gg * sigmoid4(gg) * uu; }
                u32x4 w; w.x = cvt_pk_bf16(h[0][0], h[0][1]); w.y = cvt_pk_bf16(h[0][2], h[0][3]); w.z = cvt_pk_bf16(h[1][0], h[1][1]); w.w = cvt_pk_bf16(h[1][2], h[1][3]);
                *(u32x4*)(H + blk_off(row0 + ai * HALF + m * 16, col0, DFF / 64)) = w; }
    }
};

struct EpiGLU {
    static constexpr bool NEEDS_RS = true;
    bf16_t* G; const float* ssq; const float* bias; float* out_cp;
    __device__ __forceinline__ void prep(const Unit& u, LAS float* tab, int tid) const { rs_prep(ssq, u, tab, tid); }
    __device__ __forceinline__ void operator()(f32x4 (&acc)[2][2][4][2], const Unit& u, int wr, int wc, int fr, int fq, const LAS float* tab) const { const int lane = fq * 16 + fr; (void)lane;
        const int row0 = u.pm * BM + wr * 64 + fr, col0 = u.pn * HALF + wc * 32 + 8 * fq;
        f32x4 ba[2], bg[2];
#pragma unroll
        for (int n = 0; n < 2; ++n) { ba[n] = *(const f32x4*)(bias + col0 + 4 * n); bg[n] = *(const f32x4*)(bias + D + col0 + 4 * n); }
#pragma unroll
        for (int ai = 0; ai < 2; ++ai)
#pragma unroll
            for (int m = 0; m < 4; ++m) { const float rs = tab[ai * HALF + wr * 64 + m * 16 + fr]; const int r = row0 + ai * HALF + m * 16;
                f32x4 o[2];
#pragma unroll
                for (int n = 0; n < 2; ++n) { const f32x4 a = acc[ai][0][m][n] * rs + ba[n], gt = acc[ai][1][m][n] * rs + bg[n];
                    o[n] = a * sigmoid4(gt); }
                u32x4 w; w.x = cvt_pk_bf16(o[0][0], o[0][1]); w.y = cvt_pk_bf16(o[0][2], o[0][3]); w.z = cvt_pk_bf16(o[1][0], o[1][1]); w.w = cvt_pk_bf16(o[1][2], o[1][3]);
                *(u32x4*)(G + (size_t)r * D + col0) = w;
                { const int t = r & 4095; if (t >= 4066) { float* dst = out_cp + ((size_t)(r >> 12) * 30 + (t - 4066)) * D + col0; *(f32x4*)dst = o[0]; *(f32x4*)(dst + 4) = o[1]; } }
            }
    }
};
}

namespace thin {
template <int NF, bool ABLK = false>
__device__ __forceinline__ void unit_mma(const bf16_t* Abase, int arow, int K, const bf16_t* const (&B)[NF], int tid, int wave, int lane, LAS unsigned char* lds, f32x4 (&red)[NF]) {
    f32x4 acc[2][NF];
#pragma unroll
    for (int m = 0; m < 2; ++m)
#pragma unroll
        for (int n = 0; n < NF; ++n) acc[m][n] = (f32x4){0.f, 0.f, 0.f, 0.f};
    const int kw = K >> 3, nks = kw >> 5, kb = wave * kw;
    constexpr int CH = (NF == 2) ? 12 : 4;
    for (int k0 = 0; k0 < nks; k0 += CH) {
        bf16x8 a[2][CH], b[NF][CH];
#pragma unroll
        for (int s = 0; s < CH; ++s) if (k0 + s < nks) {
#pragma unroll
            for (int m = 0; m < 2; ++m) { const int kk = kb + 32 * (k0 + s) + 8 * (lane >> 4);
                a[m][s] = *(const bf16x8*)(ABLK ? Abase + blk_off(arow + 16 * m, kk, K >> 6) : Abase + (size_t)(arow + 16 * m) * K + kk); }
#pragma unroll
            for (int n = 0; n < NF; ++n) b[n][s] = *(const bf16x8*)(B[n] + kb + 32 * (k0 + s)); }
#pragma unroll
        for (int s = 0; s < CH; ++s) if (k0 + s < nks) {
#pragma unroll
            for (int m = 0; m < 2; ++m)
#pragma unroll
                for (int n = 0; n < NF; ++n) acc[m][n] = __builtin_amdgcn_mfma_f32_16x16x32_bf16(b[n][s], a[m][s], acc[m][n], 0, 0, 0); }
    }
    __syncthreads();
    LAS f32x4* P = (LAS f32x4*)lds;
#pragma unroll
    for (int m = 0; m < 2; ++m)
#pragma unroll
        for (int n = 0; n < NF; ++n) P[(wave * 2 * NF + m * NF + n) * 64 + lane] = acc[m][n];
    __syncthreads();
    if (tid < 128) { const int m = tid >> 6;
#pragma unroll
        for (int n = 0; n < NF; ++n) { f32x4 s = P[(m * NF + n) * 64 + lane];
#pragma unroll
            for (int w = 1; w < 8; ++w) s += P[(w * 2 * NF + m * NF + n) * 64 + lane];
            red[n] = s; } }
}
__device__ __forceinline__ float rs_of(const float* ssqs, int r) {
    const f32x4* p = (const f32x4*)(ssqs + (size_t)r * 32); f32x4 a = p[0];
#pragma unroll
    for (int k = 1; k < 8; ++k) a += p[k];
    return 1.0f / sqrtf(((a.x + a.y) + (a.z + a.w)) * (1.0f / D) + RMS_EPS);
}
__device__ __forceinline__ u32x2 pk4(f32x4 v) { u32x2 w; w.x = cvt_pk_bf16(v[0], v[1]); w.y = cvt_pk_bf16(v[2], v[3]); return w; }

__device__ __forceinline__ int xcd_unit(int t, int G, int per) {
    if (G != 256) return t;
    const int x = t & 7, q = (t & 255) >> 3, i = t >> 8, l = q * per + i;
    return ((x + 8 * (l >> 3)) << 3) | (l & 7);
}
__device__ __forceinline__ void t_in(int unit, int tid, int wave, int lane, LAS unsigned char* lds, const bf16_t* XB, const bf16_t* W, const float* bias, const float* ssqs, bf16_t* U, bf16_t* V, float* vstat, float* vraw) {
    const int fr = lane & 15, fq = lane >> 4, s = unit & 7, cb = unit >> 3, c0 = 64 * cb;
    const bf16_t* const B[4] = {W + (size_t)(c0 + fr) * D + 8 * fq, W + (size_t)(c0 + 16 + fr) * D + 8 * fq, W + (size_t)(c0 + 32 + fr) * D + 8 * fq, W + (size_t)(c0 + 48 + fr) * D + 8 * fq};
    const int r = 32 * s + 16 * ((tid >> 6) & 1) + fr; float rs = 0.f; f32x4 bv[4];
    if (tid < 128) { rs = rs_of(ssqs, r);
#pragma unroll
        for (int n = 0; n < 4; ++n) bv[n] = *(const f32x4*)(bias + c0 + 16 * n + 4 * fq); }
    f32x4 red[4]; unit_mma<4>(XB, MP + 32 * s + fr, D, B, tid, wave, lane, lds, red);
    if (tid < 128) { const bool isv = (cb >= 48); const int oc = (isv ? c0 - DSGU : c0) + 4 * fq; bf16_t* O = isv ? V : U;
        float sa = 0.f, sb = 0.f;
#pragma unroll
        for (int n = 0; n < 4; ++n) { f32x4 v = red[n] * rs + bv[n];
#pragma unroll
            for (int j = 0; j < 4; ++j) v[j] = gelu_tanh(v[j]);
            *(u32x2*)(isv ? O + (size_t)(MP + r) * DSGU + oc + 16 * n : O + blk_off(MP + r, oc + 16 * n, DSGU / 64)) = pk4(v);
            if (isv) { *(f32x4*)(vraw + (size_t)r * DSGU + oc + 16 * n) = v; sa += (v[0] + v[1]) + (v[2] + v[3]); sb += (v[0] * v[0] + v[1] * v[1]) + (v[2] * v[2] + v[3] * v[3]); } }
        if (isv) { sa += SHX(sa, 16); sa += SHX(sa, 32); sb += SHX(sb, 16); sb += SHX(sb, 32);
            if (fq == 0) *(f32x2*)(vstat + (size_t)(MP + r) * 96 + (cb - 48) * 2) = (f32x2){sa, sb}; } }
}
__device__ __forceinline__ void t_in_unit(const bf16x8 (&a)[2][4], const bf16x8 (&bb)[4][4], int s, int cb, float rs, int tid, int wave, int lane, LAS unsigned char* lds, const float* bias, bf16_t* U, bf16_t* V, float* vstat, float* vraw) {
    const int fr = lane & 15, fq = lane >> 4, c0 = 64 * cb, r = 32 * s + 16 * ((tid >> 6) & 1) + fr; f32x4 bv[4];
    if (tid < 128) {
#pragma unroll
        for (int n = 0; n < 4; ++n) bv[n] = *(const f32x4*)(bias + c0 + 16 * n + 4 * fq); }
    f32x4 acc[2][4];
#pragma unroll
    for (int m = 0; m < 2; ++m)
#pragma unroll
        for (int n = 0; n < 4; ++n) acc[m][n] = (f32x4){0.f, 0.f, 0.f, 0.f};
#pragma unroll
    for (int ks = 0; ks < 4; ++ks)
#pragma unroll
        for (int m = 0; m < 2; ++m)
#pragma unroll
            for (int n = 0; n < 4; ++n) acc[m][n] = __builtin_amdgcn_mfma_f32_16x16x32_bf16(bb[n][ks], a[m][ks], acc[m][n], 0, 0, 0);
    __syncthreads();
    LAS f32x4* P = (LAS f32x4*)lds;
#pragma unroll
    for (int m = 0; m < 2; ++m)
#pragma unroll
        for (int n = 0; n < 4; ++n) P[(wave * 8 + m * 4 + n) * 64 + lane] = acc[m][n];
    __syncthreads();
    if (tid < 128) { const int m = tid >> 6; const bool isv = (cb >= 48); const int oc = (isv ? c0 - DSGU : c0) + 4 * fq; bf16_t* O = isv ? V : U;
        float sa = 0.f, sb = 0.f;
#pragma unroll
        for (int n = 0; n < 4; ++n) { f32x4 v = P[(m * 4 + n) * 64 + lane];
#pragma unroll
            for (int w = 1; w < 8; ++w) v += P[(w * 8 + m * 4 + n) * 64 + lane];
            v = v * rs + bv[n];
#pragma unroll
            for (int j = 0; j < 4; ++j) v[j] = gelu_tanh(v[j]);
            *(u32x2*)(isv ? O + (size_t)(MP + r) * DSGU + oc + 16 * n : O + blk_off(MP + r, oc + 16 * n, DSGU / 64)) = pk4(v);
            if (isv) { *(f32x4*)(vraw + (size_t)r * DSGU + oc + 16 * n) = v; sa += (v[0] + v[1]) + (v[2] + v[3]); sb += (v[0] * v[0] + v[1] * v[1]) + (v[2] * v[2] + v[3] * v[3]); } }
        if (isv) { sa += SHX(sa, 16); sa += SHX(sa, 32); sb += SHX(sb, 16); sb += SHX(sb, 32);
            if (fq == 0) *(f32x2*)(vstat + (size_t)(MP + r) * 96 + (cb - 48) * 2) = (f32x2){sa, sb}; } }
}
#define T_IN_LOADB(dst, cb_) _Pragma("unroll") for (int n = 0; n < 4; ++n) _Pragma("unroll") for (int ks = 0; ks < 4; ++ks) dst[n][ks] = *(const bf16x8*)(W + (size_t)(64 * (cb_) + 16 * n + fr) * D + kq + 32 * ks)
__device__ __forceinline__ void t_in3(int b, int tid, int wave, int lane, LAS unsigned char* lds, const bf16_t* XB, const bf16_t* W, const float* bias, const float* ssqs, bf16_t* U, bf16_t* V, float* vstat, float* vraw) {
    const int fr = lane & 15, fq = lane >> 4, s = b & 7, cbA = b >> 3, kq = wave * 128 + 8 * fq;
    bf16x8 a[2][4], b0[4][4], b1[4][4];
#pragma unroll
    for (int m = 0; m < 2; ++m)
#pragma unroll
        for (int ks = 0; ks < 4; ++ks) a[m][ks] = *(const bf16x8*)(XB + (size_t)(MP + 32 * s + 16 * m + fr) * D + kq + 32 * ks);
    T_IN_LOADB(b0, cbA); T_IN_LOADB(b1, cbA + 32);
    const float rs = (tid < 128) ? rs_of(ssqs, 32 * s + 16 * ((tid >> 6) & 1) + fr) : 0.f;
    t_in_unit(a, b0, s, cbA, rs, tid, wave, lane, lds, bias, U, V, vstat, vraw);
    T_IN_LOADB(b0, cbA + 64);
    t_in_unit(a, b1, s, cbA + 32, rs, tid, wave, lane, lds, bias, U, V, vstat, vraw);
    t_in_unit(a, b0, s, cbA + 64, rs, tid, wave, lane, lds, bias, U, V, vstat, vraw);
}
#undef T_IN_LOADB
__device__ __forceinline__ void t_res(int unit, int tid, int wave, int lane, LAS unsigned char* lds, const bf16_t* A, int K, const bf16_t* W, const float* bias, const float* base_f, bf16_t* XB, float* ssqs_out, bool dry, bool ablk) {
    const int fr = lane & 15, fq = lane >> 4, s = unit & 7, cb = unit >> 3, c0 = 32 * cb;
    const bf16_t* const B[2] = {W + (size_t)(c0 + fr) * K + 8 * fq, W + (size_t)(c0 + 16 + fr) * K + 8 * fq};
    const int r = 32 * s + 16 * ((tid >> 6) & 1) + fr; f32x4 xb[2];
    if (tid < 128) {
#pragma unroll
        for (int n = 0; n < 2; ++n) { const int c = c0 + 16 * n + 4 * fq;
            if (base_f) xb[n] = *(const f32x4*)(base_f + (size_t)r * D + c);
            else { const u32x2 t = *(const u32x2*)(XB + (size_t)(MP + r) * D + c); xb[n] = (f32x4){bf_lo(t.x), bf_hi(t.x), bf_lo(t.y), bf_hi(t.y)}; }
            if (bias) xb[n] += *(const f32x4*)(bias + c); } }
    f32x4 red[2]; if (ablk) unit_mma<2, true>(A, MP + 32 * s + fr, K, B, tid, wave, lane, lds, red); else unit_mma<2, false>(A, MP + 32 * s + fr, K, B, tid, wave, lane, lds, red);
    if (tid < 128) { float q = 0.f;
#pragma unroll
        for (int n = 0; n < 2; ++n) { const int c = c0 + 16 * n + 4 * fq; f32x4 x = xb[n] + red[n];
            if (!(PROBE_MASK && dry)) *(u32x2*)(XB + (size_t)(MP + r) * D + c) = pk4(x);
            q += (x[0] * x[0] + x[1] * x[1]) + (x[2] * x[2] + x[3] * x[3]); }
        q += SHX(q, 16); q += SHX(q, 32);
        if (fq == 0) ssqs_out[(size_t)r * 32 + cb] = q; }
}
__device__ __forceinline__ void t_gu(int unit, int tid, int wave, int lane, LAS unsigned char* lds, const bf16_t* XB, const bf16_t* W, const float* ssqs, bf16_t* H) {
    const int fr = lane & 15, fq = lane >> 4, s = unit & 7, hb = unit >> 3, h0 = 32 * hb, wrow = 256 * (h0 >> 7) + (h0 & 127) + fr;
    const bf16_t* const B[4] = {W + (size_t)wrow * D + 8 * fq, W + (size_t)(wrow + 16) * D + 8 * fq, W + (size_t)(wrow + 128) * D + 8 * fq, W + (size_t)(wrow + 144) * D + 8 * fq};
    f32x4 red[4]; unit_mma<4>(XB, MP + 32 * s + fr, D, B, tid, wave, lane, lds, red);
    if (tid < 128) { const int r = 32 * s + 16 * (tid >> 6) + fr; const float rs = rs_of(ssqs, r);
#pragma unroll
        for (int n = 0; n < 2; ++n) { f32x4 h;
#pragma unroll
            for (int j = 0; j < 4; ++j) { const float gg = red[n][j] * rs, uu = red[n + 2][j] * rs; h[j] = gg * sigmoid_f(gg) * uu; }
            *(u32x2*)(H + (size_t)(MP + r) * DFF + h0 + 16 * n + 4 * fq) = pk4(h); } }
}
__device__ __forceinline__ void t_glu(int unit, int tid, int wave, int lane, LAS unsigned char* lds, const bf16_t* XB, const bf16_t* W, const float* bias, const float* ssqs, bf16_t* G, float* out_cs) {
    const int fr = lane & 15, fq = lane >> 4, s = unit & 7, cb = unit >> 3, c0 = 32 * cb, wrow = 256 * (c0 >> 7) + (c0 & 127) + fr;
    const bf16_t* const B[4] = {W + (size_t)wrow * D + 8 * fq, W + (size_t)(wrow + 16) * D + 8 * fq, W + (size_t)(wrow + 128) * D + 8 * fq, W + (size_t)(wrow + 144) * D + 8 * fq};
    const int r = 32 * s + 16 * ((tid >> 6) & 1) + fr; float rs = 0.f; f32x4 bv[4];
    if (tid < 128) { rs = rs_of(ssqs, r);
#pragma unroll
        for (int n = 0; n < 2; ++n) { bv[n] = *(const f32x4*)(bias + c0 + 16 * n + 4 * fq); bv[n + 2] = *(const f32x4*)(bias + D + c0 + 16 * n + 4 * fq); } }
    f32x4 red[4]; unit_mma<4>(XB, MP + 32 * s + fr, D, B, tid, wave, lane, lds, red);
    if (tid < 128) { const int tt = r & 31;
#pragma unroll
        for (int n = 0; n < 2; ++n) { const int c = c0 + 16 * n + 4 * fq; const f32x4 a = red[n] * rs + bv[n], gt = red[n + 2] * rs + bv[n + 2]; f32x4 o;
#pragma unroll
            for (int j = 0; j < 4; ++j) o[j] = a[j] * sigmoid_f(gt[j]);
            *(u32x2*)(G + (size_t)(MP + r) * D + c) = pk4(o);
            if (tt >= 2) *(f32x4*)(out_cs + ((size_t)(r >> 5) * 30 + (tt - 2)) * D + c) = o; } }
}
}

#define XB_TMO      128
#define XB_XCNT(j)  (256  + 64 * (j))
#define XB_XSUB(j)  (1280 + 64 * (j))
#define XB_XGEN(j)  (2304 + 64 * (j))
#define XB_TOP      3328
#define XB_TOPGEN   3392
#define XCD_BAR_WORDS 3456
#define XB_SPIN_CAP (1u << 18)
__device__ __forceinline__ unsigned xb_ld(unsigned* p)              { return __hip_atomic_load(p, __ATOMIC_RELAXED, __HIP_MEMORY_SCOPE_AGENT); }
__device__ __forceinline__ unsigned xb_add(unsigned* p, unsigned v) { return __hip_atomic_fetch_add(p, v, __ATOMIC_RELAXED, __HIP_MEMORY_SCOPE_AGENT); }
__device__ __forceinline__ unsigned xb_xcc_id() { return (unsigned)__builtin_amdgcn_s_getreg((3 << 11) | 20) & 0xFu; }
#define XB_SPIN(cond, bar) do { unsigned _sp = 0; while (cond) { __builtin_amdgcn_s_sleep(1); \
    if ((++_sp & 255u) == 0u) { if (xb_ld(&(bar)[XB_TMO])) break; if (_sp > XB_SPIN_CAP) { atomicAdd(&(bar)[XB_TMO], 1u); break; } } } } while (0)
struct XcdBarrier { unsigned* bar; unsigned x; volatile LAS unsigned* st; };
__device__ __forceinline__ XcdBarrier xcd_barrier_post(unsigned* bar, volatile LAS unsigned* st) {
    XcdBarrier b; b.bar = bar; b.x = xb_xcc_id(); b.st = st;
    if (threadIdx.x == 0) (void)xb_add(&bar[XB_XCNT(b.x)], 1u);
    return b;
}
__device__ __forceinline__ void xcd_barrier_complete(unsigned* bar, unsigned x, unsigned& nloc, unsigned& nx) {
    const unsigned G = gridDim.x * gridDim.y * gridDim.z;
    unsigned sum, cnt, mine, sp = 0u;
    for (;;) {
        sum = 0u; cnt = 0u; mine = 0u;
#pragma unroll
        for (unsigned j = 0; j < 16; ++j) { const unsigned c = xb_ld(&bar[XB_XCNT(j)]); sum += c; cnt += (c > 0u) ? 1u : 0u; mine = (j == x) ? c : mine; }
        if (sum == G) break;
        __builtin_amdgcn_s_sleep(1);
        if ((++sp & 255u) == 0u) { if (xb_ld(&bar[XB_TMO])) break; if (sp > XB_SPIN_CAP) { atomicAdd(&bar[XB_TMO], 1u); break; } }
    }
    nloc = mine > 0u ? mine : 1u; nx = cnt > 0u ? cnt : 1u;
}
__device__ __forceinline__ void xcd_barrier(const XcdBarrier& b) {
    asm volatile("s_waitcnt vmcnt(0)" ::: "memory");
    __syncthreads();
    if (threadIdx.x == 0) {
        unsigned long long bar_i = (unsigned long long)b.bar; asm volatile("" : "+v"(bar_i)); unsigned* bar = (unsigned*)(GAS unsigned*)bar_i;
        __builtin_amdgcn_s_waitcnt(0);
        unsigned nloc = b.st[0], nx = b.st[1];
        if (nloc == 0u) { xcd_barrier_complete(bar, b.x, nloc, nx); b.st[0] = nloc; b.st[1] = nx; }
        const unsigned old = xb_add(&bar[XB_XSUB(b.x)], 1u);
        const unsigned gen = old / nloc;
        if (old + 1u == (gen + 1u) * nloc) {
            __builtin_amdgcn_fence(__ATOMIC_RELEASE, "agent");
            asm volatile("s_waitcnt vmcnt(0)" ::: "memory");
            const unsigned og = xb_add(&bar[XB_TOP], 1u);
            const unsigned tg = og / nx;
            if (og + 1u == (tg + 1u) * nx) xb_add(&bar[XB_TOPGEN], 1u);
            else XB_SPIN(xb_ld(&bar[XB_TOPGEN]) == tg, bar);
            xb_add(&bar[XB_XGEN(b.x)], 1u);
            __builtin_amdgcn_fence(__ATOMIC_ACQUIRE, "agent");
            asm volatile("s_waitcnt vmcnt(0)" ::: "memory");
        } else {
            XB_SPIN(xb_ld(&bar[XB_XGEN(b.x)]) == gen, bar);
            __builtin_amdgcn_fence(__ATOMIC_ACQUIRE, "agent");
            asm volatile("s_waitcnt vmcnt(0)" ::: "memory");
        }
    }
    __syncthreads();
}

struct Args { const float* in[25]; float* out; unsigned char* ws; int ph_lo, ph_hi, li, pad; };
enum { I_XP = 0, I_XS, I_STATE, I_GMIX, I_GFFN, I_GFIN, I_WIN, I_BIN, I_LNG, I_LNB, I_WS, I_BS, I_WOUT, I_BOUT, I_PW1, I_BPW1, I_WDW, I_BDW, I_CLNG, I_CLNB, I_PW2, I_BPW2, I_WG, I_WU, I_WD };

__device__ __forceinline__ void cvt_item(const float* W, int K, int N, const float* gsc, bf16_t* WT, int kind, LAS float* scr, int item, int lane) {
    const int nblk = N / 32, kb = item / nblk, nb = item % nblk, k0 = 64 * kb, n0 = 32 * nb;
    int row0 = n0;
    if (kind == 1) row0 = 256 * (n0 >> 7) + (n0 & 127);
    else if (kind == 2) row0 = 256 * (n0 >> 7) + (n0 & 127) + 128;
    else if (kind == 3) { const int n1 = n0 & 1023; row0 = 256 * (n1 >> 7) + (n1 & 127) + ((n0 >= 1024) ? 128 : 0); }
    float wv[32];
#pragma unroll
    for (int i = 0; i < 32; ++i) wv[i] = __builtin_nontemporal_load(&W[(size_t)(k0 + 2 * i + (lane >> 5)) * N + n0 + (lane & 31)]);
    if (gsc) {
#pragma unroll
        for (int i = 0; i < 32; ++i) wv[i] *= gsc[k0 + 2 * i + (lane >> 5)]; }
#pragma unroll
    for (int i = 0; i < 32; ++i) scr[(2 * i + (lane >> 5)) * 33 + (lane & 31)] = wv[i];
    LDS_WAIT(); asm volatile("" ::: "memory");
    const int c = lane & 7;
#pragma unroll
    for (int j = 0; j < 4; ++j) { const int n = (lane >> 3) + 8 * j; const LAS float* s = scr + (8 * c) * 33 + n;
        u32x4 o; o.x = pk2(s[0 * 33], s[1 * 33]); o.y = pk2(s[2 * 33], s[3 * 33]); o.z = pk2(s[4 * 33], s[5 * 33]); o.w = pk2(s[6 * 33], s[7 * 33]);
        *(u32x4*)(WT + (size_t)(row0 + n) * K + k0 + 8 * c) = o; }
    LDS_WAIT(); asm volatile("" ::: "memory");
}
__device__ __forceinline__ void convert_layer(int L, LAS unsigned char* lds, int gw, int NGW, int wave, int lane) {
    LAS float* scr = (LAS float*)(lds + wave * 16384);
    const int j = L >> 1; const bool sgu = !(L & 1);
    unsigned char* slot = KWS() + (sgu ? WS_SLOTA : WS_SLOTB);
    const float* w0 = sgu ? KIN(I_WIN) + (size_t)j * D * DSF : KIN(I_PW1) + (size_t)j * D * 2 * D;
    const float* w1 = sgu ? KIN(I_WOUT) + (size_t)j * DSGU * D : KIN(I_PW2) + (size_t)j * D * D;
    const int N0 = sgu ? DSF : 2 * D, K1 = sgu ? DSGU : D;
    const int I0 = (D / 64) * (N0 / 32), I1 = (K1 / 64) * (D / 32), IG = (D / 64) * (DFF / 32), ID = (DFF / 64) * (D / 32);
    bf16_t* d0 = (bf16_t*)(slot + (sgu ? SA_WIN : SB_PW1)); bf16_t* d1 = (bf16_t*)(slot + (sgu ? SA_WOUT : SB_PW2));
    bf16_t* dg = (bf16_t*)(slot + (sgu ? SA_WGU : SB_WGU)); bf16_t* dd = (bf16_t*)(slot + (sgu ? SA_WDN : SB_WDN));
    const float* gmix = KIN(I_GMIX) + L * D; const float* gffn = KIN(I_GFFN) + L * D;
    const int total = I0 + I1 + 2 * IG + ID;
    for (int it = gw; it < total; it += NGW) {
        int r = it; asm volatile("" : "+v"(r));
        if (r < I0) { cvt_item(w0, D, N0, gmix, d0, sgu ? 0 : 3, scr, r, lane); continue; } r -= I0;
        if (r < I1) { cvt_item(w1, K1, D, nullptr, d1, 0, scr, r, lane); continue; } r -= I1;
        if (r < IG) { cvt_item(KIN(I_WG) + (size_t)L * D * DFF, D, DFF, gffn, dg, 1, scr, r, lane); continue; } r -= IG;
        if (r < IG) { cvt_item(KIN(I_WU) + (size_t)L * D * DFF, D, DFF, gffn, dg, 2, scr, r, lane); continue; } r -= IG;
        cvt_item(KIN(I_WD) + (size_t)L * DFF * D, DFF, D, nullptr, dd, 0, scr, r, lane);
    }
    __syncthreads();
}

__device__ __forceinline__ void p0_rows(int gw, int NGW, int lane) {
    unsigned char* ws = KWS(); bf16_t* XB = (bf16_t*)(ws + WS_XB); float* ssq = (float*)(ws + WS_SSQA); float* ssqs = (float*)(ws + WS_SSQSA);
    for (int m = gw; m < M; m += NGW) {
        const float* xrow = (m < MP) ? KIN(I_XP) + (size_t)m * D : KIN(I_XS) + (size_t)(m - MP) * D;
        const f32x4* xr = (const f32x4*)xrow + lane; f32x4 v[4]; float s = 0.f;
#pragma unroll
        for (int jj = 0; jj < 4; ++jj) { v[jj] = __builtin_nontemporal_load(xr + 64 * jj); s += (v[jj].x * v[jj].x + v[jj].y * v[jj].y) + (v[jj].z * v[jj].z + v[jj].w * v[jj].w); }
        s = wave_sum(s, lane);
        u32x2* o8 = (u32x2*)(XB + (size_t)m * D) + lane;
#pragma unroll
        for (int jj = 0; jj < 4; ++jj) { u32x2 w; w.x = pk2(v[jj].x, v[jj].y); w.y = pk2(v[jj].z, v[jj].w); o8[64 * jj] = w; }
        if (m < MP) { if (lane < 16) ssq[(size_t)m * 16 + lane] = (lane == 0) ? s : 0.f; }
        else if (lane < 32) ssqs[(size_t)(m - MP) * 32 + lane] = (lane == 0) ? s : 0.f;
    }
}

__device__ __forceinline__ void final_rows(int gw, int NGW, int lane, bool dry) {
    float* Y = KOUT(); unsigned char* ws = KWS(); const bf16_t* XB = (const bf16_t*)(ws + WS_XB); const float* ssq = (const float*)(ws + WS_SSQA); const float* ssqs = (const float*)(ws + WS_SSQSA); const float* gf = KIN(I_GFIN);
    f32x4 gv[4];
#pragma unroll
    for (int jj = 0; jj < 4; ++jj) gv[jj] = ((const f32x4*)gf)[lane + 64 * jj];
    for (int m = gw; m < M; m += NGW) {
        const float p = (m < MP) ? ((lane < 16) ? ssq[(size_t)m * 16 + lane] : 0.f) : ((lane < 32) ? ssqs[(size_t)(m - MP) * 32 + lane] : 0.f);
        const u32x2* xr = (const u32x2*)(XB + (size_t)m * D) + lane; u32x2 t[4];
#pragma unroll
        for (int jj = 0; jj < 4; ++jj) t[jj] = __builtin_nontemporal_load(xr + 64 * jj);
        const float s = wave_sum(p, lane); const float rs = 1.0f / sqrtf(s * (1.0f / D) + RMS_EPS);
        f32x4* yr = (f32x4*)(Y + (size_t)m * D) + lane;
#pragma unroll
        for (int jj = 0; jj < 4; ++jj) { const f32x4 v = (f32x4){bf_lo(t[jj].x), bf_hi(t[jj].x), bf_lo(t[jj].y), bf_hi(t[jj].y)}; if (!(PROBE_MASK && dry)) __builtin_nontemporal_store(v * rs * gv[jj], yr + 64 * jj); }
    }
}

__device__ __forceinline__ void sample_v_rows(int j, int gw, int NGW, int lane, bool dry) {
    float* vr = KOUT() + O_SV + (size_t)j * MS * DSGU; const float* vstat = (const float*)(KWS() + WS_VSTAT);
    const float* g = KIN(I_LNG) + j * DSGU; const float* b = KIN(I_LNB) + j * DSGU;
    for (int r = gw; r < MS; r += NGW) {
        float s = 0.f, q = 0.f;
        if (lane < 48) { const f32x2 p = *(const f32x2*)(vstat + (size_t)(MP + r) * 96 + lane * 2); s = p.x; q = p.y; }
        s = wave_sum(s, lane); q = wave_sum(q, lane);
        const float mean = s * (1.0f / DSGU), var = q * (1.0f / DSGU) - mean * mean, rstd = 1.0f / sqrtf(var + LN_EPS);
        f32x4* row = (f32x4*)(vr + (size_t)r * DSGU);
        for (int k = lane; k < DSGU / 4; k += 64) { const f32x4 v = row[k]; if (!(PROBE_MASK && dry)) row[k] = (v - mean) * rstd * ((const f32x4*)g)[k] + ((const f32x4*)b)[k]; }
    }
}

constexpr int MIX_ITEMS = 512 + 24;
constexpr int MIX_VS = 520;
constexpr int MIX_WP = 0, MIX_MU = 34816, MIX_RS = 35328, MIX_C1 = 35840, MIX_C2 = 36352, MIX_V = 36864;
constexpr int MIX_LG = MIX_V + 128 * MIX_VS, MIX_LB = MIX_LG + 3072;
constexpr int MIX_BSV = MIX_LB + 3072;
static_assert(MIX_BSV + 512 <= RING_BYTES, "mix LDS map");
__device__ __forceinline__ void mix_decode(int item, int& c, int& hd, int& tb, int& te) {
    if (item < 512) { c = item >> 2; hd = item & 3; tb = 0; te = 3; } else { const int q = item - 512; c = 128 + q / 12; hd = (q % 12) / 3; tb = q % 3; te = tb + 1; }
}
#define MIX_LOAD_V(c_, hd_, t3_) _Pragma("unroll") for (int i = 0; i < 8; ++i) { const int p = tid + 512 * i, row = p >> 5, c16 = p & 31; vreg[i] = __builtin_nontemporal_load((const u32x4*)(V + (size_t)(128 * (c_) + row) * DSGU + 768 * (hd_) + 256 * (t3_) + 8 * c16)); }
#define MIX_LOAD_U(dst, c_, hd_, t3_) _Pragma("unroll") for (int mi = 0; mi < 8; ++mi) dst[mi] = *(const u32x4*)(U + blk_off(128 * (c_) + 16 * mi + fr, 768 * (hd_) + 256 * (t3_) + 32 * wave + 8 * fq, DSGU / 64))
__device__ __forceinline__ void mix_phase(int j, LAS unsigned char* lds, int tid, int wave, int lane, int c0, int G, bool dry) {
    const float* Wsl = KIN(I_WS) + (size_t)j * 4 * 128 * 128; const float* bs = KIN(I_BS) + j * 4 * 128;
    const float* lng = KIN(I_LNG) + j * DSGU; const float* lnb = KIN(I_LNB) + j * DSGU;
    unsigned char* ws = KWS();
    const float* vstat = (const float*)(ws + WS_VSTAT); bf16_t* U = (bf16_t*)(ws + WS_U); const bf16_t* V = (const bf16_t*)(ws + WS_V);
    LAS float* mu = (LAS float*)(lds + MIX_MU); LAS float* rsd = (LAS float*)(lds + MIX_RS); LAS float* c1 = (LAS float*)(lds + MIX_C1); LAS float* c2 = (LAS float*)(lds + MIX_C2);
    const int fr = lane & 15, fq = lane >> 4;
    int item = c0, c, hd, tb, te; mix_decode(item, c, hd, tb, te); int t3 = tb; bool newitem = true, more = (item < MIX_ITEMS);
    u32x4 vreg[8], ureg[8];
    if (more) { MIX_LOAD_V(c, hd, t3); MIX_LOAD_U(ureg, c, hd, t3); }
    while (more) {
        const bool smp = (c >= 128);
        __syncthreads();
        if (newitem && tid < 128) { const f32x4* p = (const f32x4*)(vstat + (size_t)(128 * c + tid) * 96); float s = 0.f, q = 0.f;
#pragma unroll 8
            for (int k = 0; k < 24; ++k) { const f32x4 v = p[k]; s += v.x + v.z; q += v.y + v.w; }
            const float mean = s * (1.0f / DSGU), var = q * (1.0f / DSGU) - mean * mean; mu[tid] = mean; rsd[tid] = 1.0f / sqrtf(var + LN_EPS); }
#pragma unroll
        for (int i = 0; i < 8; ++i) { const int p = tid + 512 * i, row = p >> 5, c16 = p & 31;
            *(LAS u32x2*)(lds + MIX_V + row * MIX_VS + c16 * 16) = (u32x2){vreg[i].x, vreg[i].y}; *(LAS u32x2*)(lds + MIX_V + row * MIX_VS + c16 * 16 + 8) = (u32x2){vreg[i].z, vreg[i].w}; }
        int nitem = item, nc = c, nhd = hd, ntb = tb, nte = te, nt3 = t3 + 1;
        if (nt3 >= te) { nitem = item + G; mix_decode(nitem, nc, nhd, ntb, nte); nt3 = ntb; }
        const bool nmore = (nitem < MIX_ITEMS);
        if (nmore) { MIX_LOAD_V(nc, nhd, nt3); } else { nc = c; nhd = hd; nt3 = t3; }
        __syncthreads();
        if (newitem) { const int i = tid >> 2, jq = tid & 3, j0 = jq * 32; const int ii = smp ? (i & 31) : i;
          const float* wrow = Wsl + ((size_t)hd * 128 + ii) * 128 + (smp ? 0 : j0);
          const int lim = smp ? ((jq == (i >> 5)) ? ii : -1) : (i - j0);
          float c1p = 0.f, c2p = 0.f;
#pragma unroll 1
          for (int jj = 0; jj < 32; jj += 8) { const f32x4 wa = *(const f32x4*)(wrow + jj), wb = *(const f32x4*)(wrow + jj + 4); const float wv[8] = {wa.x, wa.y, wa.z, wa.w, wb.x, wb.y, wb.z, wb.w}; unsigned hw[8];
#pragma unroll
              for (int e = 0; e < 8; ++e) { const float w = (jj + e <= lim) ? wv[e] : 0.f; c2p += w; hw[e] = f2bf(w * rsd[j0 + jj + e]); c1p += __builtin_bit_cast(float, hw[e] << 16) * mu[j0 + jj + e]; }
              *(LAS u32x4*)(lds + MIX_WP + i * 272 + (j0 + jj) * 2) = (u32x4){hw[0] | (hw[1] << 16), hw[2] | (hw[3] << 16), hw[4] | (hw[5] << 16), hw[6] | (hw[7] << 16)}; }
          c1p += SHX(c1p, 1); c1p += SHX(c1p, 2); c2p += SHX(c2p, 1); c2p += SHX(c2p, 2);
          if (jq == 0) { c1[i] = c1p; c2[i] = c2p; }
          if (tid < 192) *(LAS f32x4*)(lds + MIX_LG + tid * 16) = *(const f32x4*)(lng + 768 * hd + 4 * tid);
          else if (tid < 384) *(LAS f32x4*)(lds + MIX_LB + (tid - 192) * 16) = *(const f32x4*)(lnb + 768 * hd + 4 * (tid - 192));
          else { const int r = tid - 384; *(LAS float*)(lds + MIX_BSV + r * 4) = bs[hd * 128 + (smp ? (r & 31) : r)]; }
          __syncthreads(); }
        {
            const int dcol = 768 * hd + 256 * t3, d0 = dcol + 32 * wave + 8 * fq;
            f32x4 acc[8][2];
#pragma unroll
            for (int mi = 0; mi < 8; ++mi) { acc[mi][0] = (f32x4){0.f, 0.f, 0.f, 0.f}; acc[mi][1] = (f32x4){0.f, 0.f, 0.f, 0.f}; }
#pragma unroll
            for (int ks = 0; ks < 4; ++ks) { bf16x8 Bf[2];
#pragma unroll
                for (int n = 0; n < 2; ++n) { const LAS unsigned char* vb = lds + MIX_V + (32 * wave + pg8::perm32(16 * n + fr)) * 2 + (8 * fq) * MIX_VS; u32x4 t;
#pragma unroll
                    for (int e = 0; e < 4; ++e) { const unsigned lo = *(const LAS unsigned short*)(vb + (32 * ks + 2 * e) * MIX_VS), hi = *(const LAS unsigned short*)(vb + (32 * ks + 2 * e + 1) * MIX_VS); t[e] = lo | (hi << 16); }
                    Bf[n] = __builtin_bit_cast(bf16x8, t); }
#pragma unroll
                for (int mi = 2 * ks; mi < 8; ++mi) { const bf16x8 Af = *(const LAS bf16x8*)(lds + MIX_WP + (16 * mi + fr) * 272 + (32 * ks + 8 * fq) * 2);
                    acc[mi][0] = __builtin_amdgcn_mfma_f32_16x16x32_bf16(Bf[0], Af, acc[mi][0], 0, 0, 0); acc[mi][1] = __builtin_amdgcn_mfma_f32_16x16x32_bf16(Bf[1], Af, acc[mi][1], 0, 0, 0); }
                __builtin_amdgcn_sched_barrier(0); }
            const int dl = (256 * t3 + 32 * wave + 8 * fq) * 4;
            const f32x4 g0 = *(const LAS f32x4*)(lds + MIX_LG + dl), g1 = *(const LAS f32x4*)(lds + MIX_LG + dl + 16), b0 = *(const LAS f32x4*)(lds + MIX_LB + dl), b1 = *(const LAS f32x4*)(lds + MIX_LB + dl + 16);
#pragma unroll
            for (int mi = 0; mi < 8; ++mi) { const int i = 16 * mi + fr; const float c1v = c1[i], c2v = c2[i], bsv = *(const LAS float*)(lds + MIX_BSV + i * 4);
                const u32x4 uw = ureg[mi];
                const f32x4 m0 = g0 * (acc[mi][0] - c1v) + b0 * c2v + bsv, m1 = g1 * (acc[mi][1] - c1v) + b1 * c2v + bsv;
                u32x4 w; w.x = cvt_pk_bf16(bf_lo(uw.x) * m0[0], bf_hi(uw.x) * m0[1]); w.y = cvt_pk_bf16(bf_lo(uw.y) * m0[2], bf_hi(uw.y) * m0[3]);
                w.z = cvt_pk_bf16(bf_lo(uw.z) * m1[0], bf_hi(uw.z) * m1[1]); w.w = cvt_pk_bf16(bf_lo(uw.w) * m1[2], bf_hi(uw.w) * m1[3]);
                if (!(PROBE_MASK && dry)) *(u32x4*)(U + blk_off(128 * c + i, d0, DSGU / 64)) = w;
                ureg[mi] = *(const u32x4*)(U + blk_off(128 * nc + i, 768 * nhd + 256 * nt3 + 32 * wave + 8 * fq, DSGU / 64)); }
        }
        newitem = (nitem != item); more = nmore; item = nitem; c = nc; hd = nhd; tb = ntb; te = nte; t3 = nt3;
    }
    __syncthreads();
}
#undef MIX_LOAD_V
#undef MIX_LOAD_U

constexpr int CONV_RUNS = MP / 64, CONV_ITEMS = CONV_RUNS + 2 * (MS / 32);
constexpr int CONV_P = RS_OFF  , CONV_MR = RS_OFF + 1024  ;
__device__ __forceinline__ f32x2 bfx2(unsigned u) { return (f32x2){bf_lo(u), bf_hi(u)}; }
#define CONV_ROW(S) do { if ((S) < 46) { const f32x2 x_ = bfx2(*(const LAS unsigned*)(lds + ((xoff + (S) * 2048) & 0x1FFFF))); \
        _Pragma("unroll") for (int k = 0; k < 31; ++k) { const int o = (S) - k; if (o >= 0 && o < 16) cv[o] = __builtin_elementwise_fma(w[k], x_, cv[o]); } } } while (0)
#define CONV_R2(S) CONV_ROW((S)); CONV_ROW((S) + 1)
#define CONV_R4(S) CONV_R2((S)); CONV_R2((S) + 2)
#define CONV_R8(S) CONV_R4((S)); CONV_R4((S) + 4)
#define CONV_R16(S) CONV_R8((S)); CONV_R8((S) + 8)
template <int N> __device__ __forceinline__ void xred_step(const float (&v)[N], float (&w)[N / 2], int lane) {
    constexpr int H = N / 2; const bool up = (lane & H) != 0;
#pragma unroll
    for (int k = 0; k < H; ++k) { const float send = up ? v[k] : v[k + H], keep = up ? v[k + H] : v[k]; w[k] = keep + SHX(send, H); }
}
__device__ __forceinline__ void conv_half(const f32x2 (&w)[31], f32x2 bias, f32x2 lg, f32x2 lb, LAS unsigned char* lds, bf16_t* out, int xoff, int tid, int wave, int lane) {
    f32x2 cv[16];
#pragma unroll
    for (int o = 0; o < 16; ++o) cv[o] = bias;
    CONV_R16(0); CONV_R16(16); CONV_R8(32); CONV_R4(40); CONV_R2(44);
    float r32[32], r16[16], r8[8], r4[4], r2[2], r1[1];
#pragma unroll
    for (int o = 0; o < 16; ++o) { r32[2 * o] = cv[o].x + cv[o].y; r32[2 * o + 1] = cv[o].x * cv[o].x + cv[o].y * cv[o].y; }
    xred_step<32>(r32, r16, lane); xred_step<16>(r16, r8, lane); xred_step<8>(r8, r4, lane); xred_step<4>(r4, r2, lane); xred_step<2>(r2, r1, lane);
    const float tot = r1[0] + SHX(r1[0], 32);
    LAS float* P = (LAS float*)(lds + CONV_P); LAS f32x2* MR = (LAS f32x2*)(lds + CONV_MR);
    if (lane < 32) P[wave * 32 + lane] = tot;
    __syncthreads();
    if (tid < 16) { float s = 0.f, q = 0.f;
#pragma unroll
        for (int wv = 0; wv < 8; ++wv) { s += P[wv * 32 + 2 * tid]; q += P[wv * 32 + 2 * tid + 1]; }
        const float mean = s * (1.0f / D), var = q * (1.0f / D) - mean * mean; MR[tid] = (f32x2){mean, 1.0f / sqrtf(var + LN_EPS)}; }
    __syncthreads();
#pragma unroll
    for (int o = 0; o < 16; ++o) { const f32x2 mr = MR[o]; const f32x2 y = (cv[o] - mr.x) * mr.y * lg + lb; const f32x2 sg = sigmoid_pk(y);
        *(unsigned*)(out + (size_t)o * D) = cvt_pk_bf16(y.x * sg.x, y.y * sg.y); }
}
__device__ __forceinline__ void conv_stage(const bf16_t* GL, long g0, int r0, int r1, LAS unsigned char* lds, int wave, int lane) {
    for (int r = r0 + wave; r < r1; r += 8) { const char* g = (const char*)(GL + (g0 + r) * D) + lane * 16;
        __builtin_amdgcn_global_load_lds((const unsigned*)g, (LAS unsigned*)(lds + (r & 63) * 2048), 16, 0, 2);
        __builtin_amdgcn_global_load_lds((const unsigned*)(g + 1024), (LAS unsigned*)(lds + (r & 63) * 2048 + 1024), 16, 0, 2); }
}
#define CONV_SYNC() do { asm volatile("s_waitcnt vmcnt(0) lgkmcnt(0)" ::: "memory"); __syncthreads(); } while (0)
__device__ __forceinline__ void conv_phase(int j, LAS unsigned char* lds, int tid, int, int, int c0, int G) {
    unsigned char* ws = KWS();
    const bf16_t* GL = (const bf16_t*)(ws + WS_GLU); bf16_t* CA = (bf16_t*)(ws + WS_CACT);
    const float* wdw = KIN(I_WDW) + (size_t)j * 31 * D; const float* bdw = KIN(I_BDW) + j * D; const float* lng = KIN(I_CLNG) + j * D; const float* lnb = KIN(I_CLNB) + j * D;
    const float* st = KIN(I_STATE) + (size_t)j * 8 * 30 * D;
    for (int item = c0; item < CONV_ITEMS; item += G) {
        asm volatile("" : "+v"(tid));
        const int ch = 2 * tid, lane = tid & 63, wave = __builtin_amdgcn_readfirstlane(tid >> 6);
        const bool smp = (item >= CONV_RUNS); const int hsel = smp ? ((item - CONV_RUNS) & 1) : 0;
        const int t0 = smp ? MP + 32 * ((item - CONV_RUNS) >> 1) : 64 * item; const bool first = !smp && ((t0 & 4095) == 0);
        __syncthreads();
        if (smp) { conv_stage(GL, (long)t0 - 30, 30, 62, lds, wave, lane);
            const float* sp = st + (size_t)((t0 - MP) >> 5) * 30 * D + ch;
#pragma unroll
            for (int s1 = 0; s1 < 30; s1 += 10) { f32x2 sv[10];
#pragma unroll
                for (int s = 0; s < 10; ++s) sv[s] = *(const f32x2*)(sp + (size_t)(s1 + s) * D);
#pragma unroll
                for (int s = 0; s < 10; ++s) *(LAS unsigned*)(lds + (s1 + s) * 2048 + tid * 4) = cvt_pk_bf16(sv[s].x, sv[s].y);
                asm volatile("" ::: "memory"); }
        } else { conv_stage(GL, (long)t0 - 30, first ? 30 : 0, 46, lds, wave, lane);
            if (first) {
#pragma unroll
                for (int s = 0; s < 30; ++s) *(LAS unsigned*)(lds + s * 2048 + tid * 4) = 0u; } }
        f32x2 w[31];
#pragma unroll
        for (int k = 0; k < 31; ++k) w[k] = *(const f32x2*)(wdw + (size_t)k * D + ch);
        const f32x2 bias = *(const f32x2*)(bdw + ch), lg = *(const f32x2*)(lng + ch), lb = *(const f32x2*)(lnb + ch);
        bf16_t* out = CA + (size_t)t0 * D + ch;
        const int nh = smp ? 1 : 4;
#pragma nounroll
        for (int hh = 0; hh < nh; ++hh) { const int h = smp ? hsel : hh;
            CONV_SYNC();
            if (!smp && hh < 3) conv_stage(GL, (long)t0 - 30, 46 + 16 * hh, 62 + 16 * hh, lds, wave, lane);
            conv_half(w, bias, lg, lb, lds, out + (size_t)h * 16 * D, h * 32768 + tid * 4, tid, wave, lane); }
    }
    __syncthreads();
}
#undef CONV_ROW
#undef CONV_R2
#undef CONV_R4
#undef CONV_R8
#undef CONV_R16
#undef CONV_SYNC

enum { K_P0 = 0, K_GIN, K_GLU, K_MIX, K_CONV, K_RES, K_GU, K_FIN };
__host__ __device__ constexpr int phase_kind(int ph) {
    if (ph == 0) return K_P0; if (ph == NPHASE - 1) return K_FIN;
    const int L = (ph - 1) / 5, s = (ph - 1) % 5; const bool sgu = !(L & 1);
    return s == 0 ? (sgu ? K_GIN : K_GLU) : s == 1 ? (sgu ? K_MIX : K_CONV) : s == 3 ? K_GU : K_RES;
}
template <int PH>
__device__ __forceinline__ void run_phase(LAS unsigned char* lds, LAS float* rstab, int tid, int G, int bx) {
    asm volatile("" : "+v"(tid), "+s"(G), "+s"(bx));
    const int lane = tid & 63, wave = __builtin_amdgcn_readfirstlane(tid >> 6), gw = bx * 8 + wave, NGW = G * 8;
    constexpr int kind = phase_kind(PH);
    constexpr int L = (PH - 1) / 5, s = (PH - 1) % 5, j = L >> 1; constexpr bool sgu = !(L & 1);
    constexpr int reps = (PROBE_MASK && ((PROBE_MASK >> kind) & 1)) ? 2 : 1;
#pragma unroll 1
    for (int rep = 0; rep < reps; ++rep) {
        const bool dry = (rep + 1 < reps); (void)dry;
        if (PROBE_MASK && rep) { __syncthreads(); asm volatile("" : "+v"(tid), "+s"(G), "+s"(bx)); }
        pg8::StaticOrder S;
        if constexpr (kind == K_P0) {
            convert_layer(0, lds, gw, NGW, wave, lane);
            p0_rows(gw, NGW, lane);
        } else if constexpr (kind == K_FIN) {
            final_rows(gw, NGW, lane, dry);
        } else if constexpr (kind == K_GIN) {
            unsigned char* ws = KWS();
            for (int tr = 0; tr < (((PROBE_MASK >> 10) & 1) + 1); ++tr) {
                if (G == 256) thin::t_in3(bx, tid, wave, lane, lds, (const bf16_t*)(ws + WS_XB), (const bf16_t*)(ws + WS_SLOTA + SA_WIN), KIN(I_BIN) + j * DSF, (const float*)(ws + WS_SSQSA), (bf16_t*)(ws + WS_U), (bf16_t*)(ws + WS_V), (float*)(ws + WS_VSTAT), KOUT() + O_SV + (size_t)j * MS * DSGU);
                else for (int t = bx; t < 768; t += G) thin::t_in(t, tid, wave, lane, lds, (const bf16_t*)(ws + WS_XB), (const bf16_t*)(ws + WS_SLOTA + SA_WIN), KIN(I_BIN) + j * DSF, (const float*)(ws + WS_SSQSA), (bf16_t*)(ws + WS_U), (bf16_t*)(ws + WS_V), (float*)(ws + WS_VSTAT), KOUT() + O_SV + (size_t)j * MS * DSGU); }
            __syncthreads();
            pg8::Gemm g{(const bf16_t*)(ws + WS_XB), (const bf16_t*)(ws + WS_SLOTA + SA_WIN), MP, DSF, D}; S.init(MP, DSF, G, bx);
            pg8::EpiIn E{(bf16_t*)(ws + WS_U), (bf16_t*)(ws + WS_V), (float*)(ws + WS_VSTAT), KIN(I_BIN) + j * DSF, (const float*)(ws + WS_SSQA)};
            pg8::gemm_phase<pg8::EpiIn, true, true>(lds, rstab, g, S, E, tid);
        } else if constexpr (kind == K_GLU) {
            unsigned char* ws = KWS(); float* out = KOUT();
            for (int tr = 0; tr < (((PROBE_MASK >> 10) & 1) + 1); ++tr) { for (int t = bx; t < 256; t += G) thin::t_glu(thin::xcd_unit(t, G, 1), tid, wave, lane, lds, (const bf16_t*)(ws + WS_XB), (const bf16_t*)(ws + WS_SLOTB + SB_PW1), KIN(I_BPW1) + j * 2 * D, (const float*)(ws + WS_SSQSA), (bf16_t*)(ws + WS_GLU), out + O_CS + (size_t)j * 8 * 30 * D); }
            __syncthreads();
            pg8::Gemm g{(const bf16_t*)(ws + WS_XB), (const bf16_t*)(ws + WS_SLOTB + SB_PW1), MP, 2 * D, D}; S.init(MP, 2 * D, G, bx);
            pg8::EpiGLU E{(bf16_t*)(ws + WS_GLU), (const float*)(ws + WS_SSQA), KIN(I_BPW1) + j * 2 * D, out + O_CP + (size_t)j * 4 * 30 * D};
            pg8::gemm_phase<pg8::EpiGLU, true, true>(lds, rstab, g, S, E, tid);
        } else if constexpr (kind == K_MIX) {
            sample_v_rows(j, gw, NGW, lane, dry);
            mix_phase(j, lds, tid, wave, lane, bx, G, dry);
        } else if constexpr (kind == K_CONV) {
            conv_phase(j, lds, tid, wave, lane, bx, G);
        } else if constexpr (kind == K_GU) {
            unsigned char* ws = KWS();
            const bf16_t* W = (const bf16_t*)(ws + (sgu ? WS_SLOTA + SA_WGU : WS_SLOTB + SB_WGU));
            if constexpr (L <= 2) { constexpr int NFULL = (M / 256 * (NGU / 256)) % 256;
                if (bx >= NFULL) convert_layer(L + 1, lds, (bx - NFULL) * 8 + wave, (G - NFULL) * 8, wave, lane); }
            pg8::Gemm g{(const bf16_t*)(ws + WS_XB), W, M, NGU, D}; S.init(M, NGU, G, bx);
            pg8::EpiGU E{(bf16_t*)(ws + WS_HID), (const float*)(ws + WS_SSQB), (const float*)(ws + WS_SSQSB)};
            pg8::gemm_phase<pg8::EpiGU, true, true>(lds, rstab, g, S, E, tid);
        } else {
            unsigned char* ws = KWS();
            constexpr int K = (s == 2) ? (sgu ? DSGU : D) : DFF;
            constexpr bool ABLK_A = !(s == 2 && !sgu);
            const bf16_t* A = (const bf16_t*)(ws + ((s == 2) ? (sgu ? WS_U : WS_CACT) : WS_HID));
            const bf16_t* W = (const bf16_t*)(ws + ((s == 2) ? (sgu ? WS_SLOTA + SA_WOUT : WS_SLOTB + SB_PW2) : (sgu ? WS_SLOTA + SA_WDN : WS_SLOTB + SB_WDN)));
            const float* bias = (s == 2) ? (sgu ? KIN(I_BOUT) + j * D : KIN(I_BPW2) + j * D) : nullptr;
            float* ssqo = (float*)(ws + ((s == 2) ? WS_SSQB : WS_SSQA)); float* ssqso = (float*)(ws + ((s == 2) ? WS_SSQSB : WS_SSQSA));
            const float* bp = nullptr; const float* bsp = nullptr;
            if constexpr (L == 0 && s == 2) { bp = KIN(I_XP); bsp = KIN(I_XS); }
            for (int tr = 0; tr < (((PROBE_MASK >> 10) & 1) + 1); ++tr) { for (int t = bx; t < 256; t += G) thin::t_res(thin::xcd_unit(t, G, 1), tid, wave, lane, lds, A, K, W, bias, bsp, (bf16_t*)(ws + WS_XB), ssqso, dry || (PROBE_MASK && tr == 0 && ((PROBE_MASK >> 10) & 1)), ABLK_A); }
            __syncthreads();
            pg8::Gemm g{A, W, MP, D, K};
            pg8::EpiRes E{bp, (bf16_t*)(ws + WS_XB), ssqo, bias, dry};
            S.init(MP, D, G, bx);
            pg8::gemm_phase<pg8::EpiRes, true, true, ABLK_A>(lds, rstab, g, S, E, tid);
        }
    }
}

__global__ void __launch_bounds__(512, 2) trunk_fwd(Args args) {
    extern __shared__ __attribute__((aligned(16))) unsigned char lds_raw[];
    LAS unsigned char* lds = (LAS unsigned char*)lds_raw;
    const int tid0 = threadIdx.x;
    const int G0 = gridDim.x, bx0 = blockIdx.x;
    volatile LAS unsigned* MISC = (volatile LAS unsigned*)(lds + MISC_OFF);
    LAS float* rstab = (LAS float*)(lds + RS_OFF);
    for (int u = tid0; u < (LDS_BYTES - LDSCTL_OFF) / 4; u += 512) ((LAS unsigned*)(lds + LDSCTL_OFF))[u] = 0u;
    __syncthreads();
    const int ph_lo = args.ph_lo, ph_hi = args.ph_hi;
    XcdBarrier bar; bar.bar = nullptr; bar.x = 0; bar.st = nullptr;
    if (ph_hi - ph_lo > 1) bar = xcd_barrier_post((unsigned*)(KWS() + WS_CTL) + CW_BAR, MISC + 8);
    unsigned long long dsum = 0ull;
#define PHASE(k) if (ph_lo <= (k) && (k) < ph_hi) { const unsigned long long t0_ = (PROBE_T >> (k)) & 1u ? __builtin_amdgcn_s_memrealtime() : 0ull; run_phase<k>(lds, rstab, tid0, G0, bx0); \
        if (((PROBE_T >> (k)) & 1u) && (PROBE_T >> 31)) dsum += __builtin_amdgcn_s_memrealtime() - t0_; \
        if ((k) + 1 < ph_hi) { bar.bar = (unsigned*)(KWS() + WS_CTL) + CW_BAR; xcd_barrier(bar); if ((PROBE_MASK >> 9) & 1) xcd_barrier(bar); } \
        if (((PROBE_T >> (k)) & 1u) && !(PROBE_T >> 31)) dsum += __builtin_amdgcn_s_memrealtime() - t0_; }
    PHASE(0) PHASE(1) PHASE(2) PHASE(3) PHASE(4) PHASE(5) PHASE(6) PHASE(7) PHASE(8) PHASE(9) PHASE(10)
    PHASE(11) PHASE(12) PHASE(13) PHASE(14) PHASE(15) PHASE(16) PHASE(17) PHASE(18) PHASE(19) PHASE(20) PHASE(21)
#undef PHASE
    if (PROBE_T && bx0 == 0 && tid0 == 0) { const unsigned long long t = __builtin_amdgcn_s_memrealtime(); while (__builtin_amdgcn_s_memrealtime() - t < 8ull * dsum) __builtin_amdgcn_s_sleep(16); }
}

extern "C" void kernel_launch(void* const* d_in, const int* in_sizes, int n_in, void* d_out, int out_size, void* d_ws, size_t ws_size, hipStream_t stream) {
    static int grid = 0;
    constexpr int NL = MK_N_LAUNCHES;
    if (grid == 0) {
        if (n_in != 25 || in_sizes[0] != MP * D || (size_t)out_size != O_END || ws_size < WS_END) {
            fprintf(stderr, "kernel_launch: unexpected shapes: n_in %d in0 %d out %d ws %zu (need %zu)\n", n_in, n_in > 0 ? in_sizes[0] : -1, out_size, ws_size, (size_t)WS_END); grid = -1; return; }
        int dev = 0, cus = 0, per_cu = 0;
        if (hipGetDevice(&dev) != hipSuccess || hipDeviceGetAttribute(&cus, hipDeviceAttributeMultiprocessorCount, dev) != hipSuccess) { grid = -1; return; }
        if (hipFuncSetAttribute((const void*)trunk_fwd, hipFuncAttributeMaxDynamicSharedMemorySize, LDS_BYTES) != hipSuccess) { fprintf(stderr, "kernel_launch: hipFuncSetAttribute failed\n"); grid = -1; return; }
        if (hipOccupancyMaxActiveBlocksPerMultiprocessor(&per_cu, (const void*)trunk_fwd, 512, LDS_BYTES) != hipSuccess || per_cu < 1) fprintf(stderr, "kernel_launch: occupancy query reports %d workgroups per CU\n", per_cu);
        (void)hipGetLastError();
        grid = cus;
    }
    if (grid < 0) return;
    if (hipMemsetAsync((char*)d_ws + WS_CTL + (size_t)CW_BAR * 4, 0, (size_t)XCD_BAR_WORDS * 4, stream) != hipSuccess)     { fprintf(stderr, "kernel_launch: memset failed\n"); return; }
    Args a{};
    for (int i = 0; i < 25; ++i) a.in[i] = (const float*)d_in[i];
    a.out = (float*)d_out; a.ws = (unsigned char*)d_ws;
    if (NL == 1) { a.ph_lo = 0; a.ph_hi = NPHASE; hipLaunchKernelGGL(trunk_fwd, dim3(grid), dim3(512), LDS_BYTES, stream, a); }
    else for (int ph = 0; ph < NPHASE; ++ph) { a.ph_lo = ph; a.ph_hi = ph + 1; hipLaunchKernelGGL(trunk_fwd, dim3(grid), dim3(512), LDS_BYTES, stream, a); }
    const hipError_t le = hipPeekAtLastError();
    if (le != hipSuccess) fprintf(stderr, "kernel_launch: launch failed: %s\n", hipGetErrorName(le));
}
```

```cpp
#include <hip/hip_runtime.h>
#include <cstdio>
#include <cstdint>

#ifndef MK_N_LAUNCHES
#define MK_N_LAUNCHES 1
#endif

#ifndef PROBE_T
#define PROBE_T 0u
#endif
#ifndef PROBE_MASK
#define PROBE_MASK 0
#endif
#define LAS __attribute__((address_space(3)))
#define GAS __attribute__((address_space(1)))
typedef unsigned short bf16_t;
typedef short bf16x8 __attribute__((ext_vector_type(8)));
typedef float f32x4 __attribute__((ext_vector_type(4)));
typedef float f32x2 __attribute__((ext_vector_type(2)));
typedef unsigned u32x4 __attribute__((ext_vector_type(4)));
typedef unsigned u32x2 __attribute__((ext_vector_type(2)));

constexpr int D = 1024, MP = 16384, MS = 256, M = MP + MS, DSGU = 3072, DSF = 6144, DFF = 2816, NGU = 2 * DFF;
constexpr int NPHASE = 22;
constexpr float RMS_EPS = 1e-6f, LN_EPS = 1e-5f;

constexpr size_t O_Y = 0, O_CP = (size_t)M * D, O_CS = O_CP + 2 * 4 * 30 * 1024, O_SV = O_CS + 2 * 8 * 30 * 1024, O_END = O_SV + 2 * 8 * 32 * 3072;

constexpr size_t MiB = 1u << 20;
constexpr size_t WS_CTL = 0, CTL_ZERO_BYTES = 1 * MiB;
constexpr size_t WS_SSQA = 1 * MiB, WS_SSQB = WS_SSQA + 1064960, WS_VSTAT = WS_SSQB + 1064960;
constexpr size_t WS_SSQSA = WS_VSTAT + 6389760, WS_SSQSB = WS_SSQSA + 32768;
constexpr size_t WS_SLOTA = 9 * MiB + 256 * 1024, WS_SLOTB = WS_SLOTA + 36175872, WS_XB = WS_SLOTB + 23592960, WS_U = WS_XB + 34078720, WS_V = WS_U + 102236160, WS_END = WS_V + 102236160;
constexpr size_t WS_HID = WS_U, WS_GLU = WS_U, WS_CACT = WS_U + 33 * MiB;
static_assert((size_t)M * 96 * 4 == 6389760 && WS_SSQSB + 32768 <= WS_SLOTA, "ws map");
static_assert((size_t)M * 16 * 4 <= 1064960 && (size_t)M * D * 2 == 34078720 && (size_t)M * DSGU * 2 == 102236160, "ws map");
static_assert(WS_END <= 310173696, "ws map: must fit sum(inputs) bytes");
static_assert(WS_HID + (size_t)M * DFF * 2 <= WS_V && WS_GLU + (size_t)M * D * 2 <= WS_CACT, "ws map");
constexpr size_t SA_WIN = 0, SA_WOUT = 12582912, SA_WGU = 18874368, SA_WDN = 30408704;
constexpr size_t SB_PW1 = 0, SB_PW2 = 4194304, SB_WGU = 6291456, SB_WDN = 17825792;

constexpr int CW_BAR = 4096;

constexpr int RING_BYTES = 131072, RS_OFF = RING_BYTES  , LDSCTL_OFF = RING_BYTES + 2048, MISC_OFF = LDSCTL_OFF + 320, LDS_BYTES = 147456;

__device__ __forceinline__ unsigned cvt_pk_bf16(float lo, float hi) { unsigned r; asm volatile("v_cvt_pk_bf16_f32 %0, %1, %2" : "=v"(r) : "v"(lo), "v"(hi)); return r; }
__device__ __forceinline__ unsigned f2bf(float f) { unsigned u = __builtin_bit_cast(unsigned, f); return (u + 0x7fffu + ((u >> 16) & 1u)) >> 16; }
__device__ __forceinline__ unsigned pk2(float lo, float hi) { return f2bf(lo) | (f2bf(hi) << 16); }
__device__ __forceinline__ float bf_lo(unsigned w) { return __builtin_bit_cast(float, w << 16); }
__device__ __forceinline__ float bf_hi(unsigned w) { return __builtin_bit_cast(float, w & 0xffff0000u); }
__device__ __forceinline__ float gelu_tanh(float x) {
    const float y = x * (1.0f + 0.044715f * x * x);
    return x * __builtin_amdgcn_rcpf(1.0f + __builtin_amdgcn_exp2f(-2.302208198f * y));
}
__device__ __forceinline__ f32x2 gelu_pk(f32x2 x) {
    const f32x2 t = x * x, u = t * (-0.10294324f) + (-2.302208198f), m = x * u;
    f32x2 e; e.x = __builtin_amdgcn_exp2f(m.x); e.y = __builtin_amdgcn_exp2f(m.y);
    const f32x2 d = e + 1.0f; f32x2 r; r.x = __builtin_amdgcn_rcpf(d.x); r.y = __builtin_amdgcn_rcpf(d.y);
    return x * r;
}
__device__ __forceinline__ f32x2 sigmoid_pk(f32x2 x) {
    const f32x2 m = x * (-1.4426950409f); f32x2 e; e.x = __builtin_amdgcn_exp2f(m.x); e.y = __builtin_amdgcn_exp2f(m.y);
    const f32x2 d = e + 1.0f; f32x2 r; r.x = __builtin_amdgcn_rcpf(d.x); r.y = __builtin_amdgcn_rcpf(d.y); return r;
}
__device__ __forceinline__ f32x4 gelu4(f32x4 v) { const f32x2 a = gelu_pk((f32x2){v[0], v[1]}), b = gelu_pk((f32x2){v[2], v[3]}); return (f32x4){a.x, a.y, b.x, b.y}; }
__device__ __forceinline__ f32x4 sigmoid4(f32x4 v) { const f32x2 a = sigmoid_pk((f32x2){v[0], v[1]}), b = sigmoid_pk((f32x2){v[2], v[3]}); return (f32x4){a.x, a.y, b.x, b.y}; }
__device__ __forceinline__ float sigmoid_f(float x) { return __builtin_amdgcn_rcpf(1.0f + __builtin_amdgcn_exp2f(-1.4426950409f * x)); }
#define SHX(v, m) __builtin_bit_cast(float, __builtin_amdgcn_ds_bpermute(((lane) ^ (m)) << 2, __builtin_bit_cast(int, (float)(v))))
__device__ __forceinline__ float wave_sum(float v, int lane) {
#pragma unroll
    for (int o = 1; o < 64; o <<= 1) v += SHX(v, o);
    return v;
}
__device__ __forceinline__ size_t blk_off(int row, int col, int KT) { return ((((size_t)(row >> 8) * KT + (col >> 6)) * 256 + (row & 255)) * 64 + (col & 63)); }
#define LDS_WAIT() asm volatile("s_waitcnt lgkmcnt(0)" ::: "memory")
#define VM_WAIT() asm volatile("s_waitcnt vmcnt(0)" ::: "memory")

__device__ __forceinline__ unsigned long long karg_u64(int idx) {
    const unsigned long long k = (unsigned long long)__builtin_amdgcn_kernarg_segment_ptr(); unsigned long long v;
    asm volatile("s_load_dwordx2 %0, %1, %2\n\ts_waitcnt lgkmcnt(0)" : "=s"(v) : "s"(k), "i"(idx * 8)); return v;
}
#define KIN(idx) ((const float*)(const GAS float*)karg_u64(idx))
#define KOUT() ((float*)(GAS float*)karg_u64(25))
#define KWS() ((unsigned char*)(GAS unsigned char*)karg_u64(26))

namespace pg8 {
constexpr int BM = 256, BK = 64, HALF = 128, HTB = HALF * BK * 2, STAGE_BYTES = 8 * HTB, NXCD = 8, WGM = 8;
__host__ __device__ __forceinline__ int lds_byte(int r, int c) { const int st = (r >> 4) * 2 + (c >> 5), rr = r & 15, cc = c & 31, ob = rr * 64 + cc * 2; return st * 1024 + (ob ^ (((ob >> 9) & 1) << 5)); }
__host__ __device__ __forceinline__ void stage_rc(int b, int& R, int& C) { const int st = b / 1024, sb = b % 1024, swz = sb ^ (((sb >> 9) & 1) << 5); R = (st >> 1) * 16 + swz / 64; C = (st & 1) * 32 + (swz % 64) / 2; }
__host__ __device__ __forceinline__ int perm32(int rho) { const int n = rho >> 4, i = rho & 15; return 8 * (i >> 2) + 4 * n + (i & 3); }

struct Unit { int pm, pn; };
struct Gemm { const bf16_t* A; const bf16_t* Bt; int M, N, K; };

struct StaticOrder {
    int nM, nN, nwg, G, c, nextra;
    __device__ void init(int M_, int N_, int G_, int c_) { nM = M_ / BM; nN = N_ / BM; nextra = 0; if (nM > 64) { nextra = (nM - 64) * nN; nM = 64; } nwg = nM * nN; G = G_; c = c_; }
    __device__ bool next(int i, Unit& u) const {
        const long L = (long)i * G + c; if (L >= nwg) { if (L >= nwg + nextra) return false; u.pm = 64 + (int)(L - nwg) / nN; u.pn = (int)(L - nwg) % nN; return true; }
        int wgid = (int)L; { const int q = nwg / NXCD, r = nwg % NXCD, xcd = wgid % NXCD, off = wgid / NXCD; wgid = (xcd < r ? xcd * (q + 1) : r * (q + 1) + (xcd - r) * q) + off; }
        const int nig = WGM * nN, gid = wgid / nig, fm = gid * WGM, gsz = (nM - fm) < WGM ? (nM - fm) : WGM;
        u.pm = fm + ((wgid % nig) % gsz); u.pn = (wgid % nig) / gsz; return true;
    }
};

template <class Epi, bool ALIGN_EPI, bool SP2, bool ABLK = false>
__device__ __forceinline__ void gemm_phase(LAS unsigned char* lds, LAS float* rstab, const Gemm g, const StaticOrder& S, const Epi& E, const int tid) {
    const int wid = __builtin_amdgcn_readfirstlane(tid >> 6), lane = tid & 63, wr = wid >> 2, wc = wid & 3, fr = lane & 15, fq = lane >> 4;
    const int K = g.K, nt = K / BK;
    unsigned voffA[2], voffB[2];
#pragma unroll
    for (int i = 0; i < 2; ++i) { int R, C; stage_rc(tid * 16 + i * 8192, R, C); const int Rb = (R & ~31) + perm32(R & 31);
        voffA[i] = (unsigned)(R * (ABLK ? BK : K) + C) * 2u; voffB[i] = (unsigned)(Rb * K + C) * 2u; }
    const size_t kstep = (size_t)(BK * 2);
    const size_t hstep = (size_t)HALF * K * 2;
    const size_t tstep = 2 * hstep;
    const size_t kstepA = ABLK ? (size_t)BM * BK * 2 : kstep, hstepA = ABLK ? (size_t)HALF * BK * 2 : hstep, tstepA = ABLK ? (size_t)(K / BK) * BM * BK * 2 : tstep;
    const unsigned ldsw = (unsigned)wid * 1024u;
    const int aoff = lds_byte(wr * 64 + fr, fq * 8), boff = lds_byte(wc * 32 + fr, fq * 8);
#define PG8_SA(b, h) (((b) * 2 + (h)) * HTB)
#define PG8_SB(b, h) ((4 + (b) * 2 + (h)) * HTB)
#define PG8_STAGE(bufoff, gbase, voff) do { _Pragma("unroll") for (int _i = 0; _i < 2; ++_i) \
        __builtin_amdgcn_global_load_lds((const unsigned*)((const char*)(gbase) + (voff)[_i]), (LAS unsigned*)(lds + (bufoff) + ldsw + _i * 8192), 16, 0, 0); } while (0)
#define PG8_LDA(dst, b, h) do { _Pragma("unroll") for (int m = 0; m < 4; ++m) _Pragma("unroll") for (int k = 0; k < 2; ++k) dst[m][k] = *(const LAS bf16x8*)(lds + PG8_SA(b, h) + aoff + m * 2048 + k * 1024); } while (0)
#define PG8_LDB(dst, b, h) do { _Pragma("unroll") for (int n = 0; n < 2; ++n) _Pragma("unroll") for (int k = 0; k < 2; ++k) dst[n][k] = *(const LAS bf16x8*)(lds + PG8_SB(b, h) + boff + n * 2048 + k * 1024); } while (0)
#define PG8_MMA(ai, bj, At, Bt) do { __builtin_amdgcn_s_setprio(1); _Pragma("unroll") for (int m = 0; m < 4; ++m) _Pragma("unroll") for (int n = 0; n < 2; ++n) _Pragma("unroll") for (int k = 0; k < 2; ++k) \
        acc[ai][bj][m][n] = __builtin_amdgcn_mfma_f32_16x16x32_bf16(Bt[n][k], At[m][k], acc[ai][bj][m][n], 0, 0, 0); __builtin_amdgcn_s_setprio(0); } while (0)
#define PG8_WAIT_V(n) asm volatile("s_waitcnt vmcnt(" #n ")" ::: "memory")
#define PG8_WAIT_L(n) asm volatile("s_waitcnt lgkmcnt(" #n ")" ::: "memory")
#define PG8_BAR __builtin_amdgcn_s_barrier()
#define PG8_SCHED __builtin_amdgcn_sched_barrier(0)
#define PG8_PTRS(u, pa, pb) do { pa = (const char*)g.A + (size_t)(u).pm * tstepA; pb = (const char*)g.Bt + (size_t)(u).pn * tstep; } while (0)
    Unit cur, nxt; int ui = 0;
    if (!S.next(0, cur)) return;
    f32x4 acc[2][2][4][2];
#pragma unroll
    for (int a = 0; a < 2; ++a)
#pragma unroll
        for (int b = 0; b < 2; ++b)
#pragma unroll
            for (int m = 0; m < 4; ++m)
#pragma unroll
                for (int n = 0; n < 2; ++n) acc[a][b][m][n] = (f32x4){0.f, 0.f, 0.f, 0.f};
    bf16x8 At[4][2], B0[2][2], B1[2][2];
    const char* cA; const char* cB; PG8_PTRS(cur, cA, cB);
    if (Epi::NEEDS_RS) { if (tid < 256) E.prep(cur, rstab, tid); }
    if constexpr (SP2) {
        PG8_STAGE(PG8_SB(0, 0), cB, voffB); PG8_STAGE(PG8_SB(0, 1), cB + hstep, voffB); PG8_STAGE(PG8_SA(0, 0), cA, voffA); PG8_STAGE(PG8_SA(0, 1), cA + hstepA, voffA);
        if (wr == 1) PG8_BAR;
        PG8_WAIT_V(2); PG8_BAR;
        PG8_STAGE(PG8_SB(1, 0), cB + kstep, voffB); PG8_STAGE(PG8_SA(1, 0), cA + kstepA, voffA); PG8_STAGE(PG8_SB(1, 1), cB + hstep + kstep, voffB);
        PG8_WAIT_V(6); PG8_BAR;
    } else {
        PG8_STAGE(PG8_SB(0, 0), cB, voffB); PG8_STAGE(PG8_SA(0, 0), cA, voffA); PG8_STAGE(PG8_SB(0, 1), cB + hstep, voffB); PG8_STAGE(PG8_SA(0, 1), cA + hstepA, voffA);
        if (wr == 1) PG8_BAR;
        PG8_WAIT_V(4); PG8_BAR;
        PG8_STAGE(PG8_SB(1, 0), cB + kstep, voffB); PG8_STAGE(PG8_SA(1, 0), cA + kstepA, voffA); PG8_STAGE(PG8_SB(1, 1), cB + hstep + kstep, voffB);
        PG8_WAIT_V(6); PG8_BAR;
    }
    for (;;) {
        const bool has_next = S.next(ui + 1, nxt);
        const char* nA = cA; const char* nB = cB; if (has_next) PG8_PTRS(nxt, nA, nB);
        for (int t = 0; t < nt; t += 2) {
            const bool last = (t == nt - 2);
            const char* a1 = cA + (size_t)(t + 1) * kstepA;
            const char* a2 = last ? nA : cA + (size_t)(t + 2) * kstepA; const char* b2 = last ? nB : cB + (size_t)(t + 2) * kstep;
            const char* a3 = a2 + kstepA; const char* b3 = b2 + kstep;
            if constexpr (SP2) {
            PG8_LDB(B0, 0, 0); PG8_LDB(B1, 0, 1); PG8_SCHED; PG8_LDA(At, 0, 0); PG8_STAGE(PG8_SA(1, 1), a1 + hstepA, voffA);
            PG8_WAIT_V(8); PG8_WAIT_L(0); PG8_BAR; PG8_MMA(0, 0, At, B0); PG8_MMA(0, 1, At, B1); PG8_BAR; PG8_SCHED;
            PG8_LDA(At, 0, 1); PG8_STAGE(PG8_SB(0, 0), b2, voffB); PG8_STAGE(PG8_SB(0, 1), b2 + hstep, voffB); PG8_STAGE(PG8_SA(0, 0), a2, voffA);
            PG8_WAIT_V(8); PG8_WAIT_L(0); PG8_BAR; PG8_MMA(1, 0, At, B0); PG8_MMA(1, 1, At, B1); PG8_BAR; PG8_SCHED;
            PG8_LDB(B0, 1, 0); PG8_LDB(B1, 1, 1); PG8_SCHED; PG8_LDA(At, 1, 0); PG8_STAGE(PG8_SA(0, 1), a2 + hstepA, voffA);
            PG8_WAIT_V(8); PG8_WAIT_L(0); PG8_BAR; PG8_MMA(0, 0, At, B0); PG8_MMA(0, 1, At, B1); PG8_BAR; PG8_SCHED;
            PG8_LDA(At, 1, 1); PG8_STAGE(PG8_SB(1, 0), b3, voffB); PG8_STAGE(PG8_SB(1, 1), b3 + hstep, voffB); PG8_STAGE(PG8_SA(1, 0), a3, voffA);
            PG8_WAIT_V(8); PG8_WAIT_L(0); PG8_BAR; PG8_MMA(1, 0, At, B0); PG8_MMA(1, 1, At, B1); PG8_BAR; PG8_SCHED;
            } else {
            PG8_LDB(B0, 0, 0); PG8_SCHED; PG8_LDA(At, 0, 0); PG8_STAGE(PG8_SA(1, 1), a1 + hstepA, voffA);
            PG8_WAIT_L(8); PG8_BAR; PG8_WAIT_L(0); PG8_MMA(0, 0, At, B0); PG8_BAR; PG8_SCHED;
            PG8_LDB(B1, 0, 1); PG8_STAGE(PG8_SB(0, 0), b2, voffB);
            PG8_BAR; PG8_WAIT_L(0); PG8_MMA(0, 1, At, B1); PG8_BAR;
            PG8_LDA(At, 0, 1); PG8_STAGE(PG8_SA(0, 0), a2, voffA);
            PG8_BAR; PG8_WAIT_L(0); PG8_MMA(1, 0, At, B0); PG8_BAR; PG8_SCHED;
            PG8_STAGE(PG8_SB(0, 1), b2 + hstep, voffB);
            PG8_WAIT_V(6); PG8_BAR; PG8_MMA(1, 1, At, B1); PG8_BAR;
            PG8_LDB(B0, 1, 0); PG8_SCHED; PG8_LDA(At, 1, 0); PG8_STAGE(PG8_SA(0, 1), a2 + hstepA, voffA);
            PG8_WAIT_L(8); PG8_BAR; PG8_WAIT_L(0); PG8_MMA(0, 0, At, B0); PG8_BAR; PG8_SCHED;
            PG8_LDB(B1, 1, 1); PG8_STAGE(PG8_SB(1, 0), b3, voffB);
            PG8_BAR; PG8_WAIT_L(0); PG8_MMA(0, 1, At, B1); PG8_BAR;
            PG8_LDA(At, 1, 1); PG8_STAGE(PG8_SA(1, 0), a3, voffA);
            PG8_BAR; PG8_WAIT_L(0); PG8_MMA(1, 0, At, B0); PG8_BAR; PG8_SCHED;
            PG8_STAGE(PG8_SB(1, 1), b3 + hstep, voffB);
            PG8_WAIT_V(6); PG8_BAR; PG8_MMA(1, 1, At, B1); PG8_BAR;
            }
        }
        if constexpr (ALIGN_EPI) { if (wr == 0) PG8_BAR; }
        E(acc, cur, wr, wc, fr, fq, rstab + (ui & 1) * 256);
        if (!has_next) break;
        if (Epi::NEEDS_RS) { if (tid < 256) E.prep(nxt, rstab + ((ui + 1) & 1) * 256, tid); }
#pragma unroll
        for (int a = 0; a < 2; ++a)
#pragma unroll
            for (int b = 0; b < 2; ++b)
#pragma unroll
                for (int m = 0; m < 4; ++m)
#pragma unroll
                    for (int n = 0; n < 2; ++n) acc[a][b][m][n] = (f32x4){0.f, 0.f, 0.f, 0.f};
        cur = nxt; cA = nA; cB = nB; ++ui;
        if constexpr (ALIGN_EPI) { if (wr == 1) PG8_BAR; }
    }
    PG8_WAIT_V(0);
    if constexpr (!ALIGN_EPI) { if (wr == 0) PG8_BAR; }
    PG8_BAR;
#undef PG8_SA
#undef PG8_SB
#undef PG8_STAGE
#undef PG8_LDA
#undef PG8_LDB
#undef PG8_MMA
#undef PG8_WAIT_V
#undef PG8_WAIT_L
#undef PG8_BAR
#undef PG8_SCHED
#undef PG8_PTRS
}

__device__ __forceinline__ void rs_prep(const float* ssq, const Unit& u, LAS float* tab, int tid) {
    const f32x4* p = (const f32x4*)(ssq + (size_t)(u.pm * BM + tid) * 16);
    const f32x4 a = p[0], b = p[1], c = p[2], d = p[3];
    const f32x4 s4 = (a + b) + (c + d); const float s = (s4.x + s4.y) + (s4.z + s4.w);
    VM_WAIT();
    tab[tid] = 1.0f / sqrtf(s * (1.0f / D) + RMS_EPS);
}

struct EpiIn {
    static constexpr bool NEEDS_RS = true;
    bf16_t* U; bf16_t* V; float* vstat; const float* bias; const float* ssq;
    __device__ __forceinline__ void prep(const Unit& u, LAS float* tab, int tid) const { rs_prep(ssq, u, tab, tid); }
    __device__ __forceinline__ void operator()(f32x4 (&acc)[2][2][4][2], const Unit& u, int wr, int wc, int fr, int fq, const LAS float* tab) const { const int lane = fq * 16 + fr; (void)lane;
        const bool isv = (u.pn >= 12); const int pv = u.pn - 12;
        const int row0 = u.pm * BM + wr * 64 + fr, col0 = (isv ? pv : u.pn) * BM + wc * 32 + 8 * fq, bcol0 = u.pn * BM + wc * 32 + 8 * fq;
        bf16_t* O = isv ? V : U;
        f32x4 bv[2][2];
#pragma unroll
        for (int bj = 0; bj < 2; ++bj)
#pragma unroll
            for (int n = 0; n < 2; ++n) bv[bj][n] = *(const f32x4*)(bias + bcol0 + bj * HALF + 4 * n);
#pragma unroll
        for (int ai = 0; ai < 2; ++ai)
#pragma unroll
            for (int m = 0; m < 4; ++m) { const int rl = ai * HALF + wr * 64 + m * 16 + fr; const float rs = tab[rl];
                bf16_t* rowp = isv ? O + (size_t)(row0 + ai * HALF + m * 16) * DSGU + col0 : O + blk_off(row0 + ai * HALF + m * 16, col0, DSGU / 64);
                float sa = 0.f, sb = 0.f;
#pragma unroll
                for (int bj = 0; bj < 2; ++bj) { f32x4 v0 = acc[ai][bj][m][0] * rs + bv[bj][0], v1 = acc[ai][bj][m][1] * rs + bv[bj][1];
                    v0 = gelu4(v0); v1 = gelu4(v1);
                    u32x4 w; w.x = cvt_pk_bf16(v0[0], v0[1]); w.y = cvt_pk_bf16(v0[2], v0[3]); w.z = cvt_pk_bf16(v1[0], v1[1]); w.w = cvt_pk_bf16(v1[2], v1[3]);
                    *(u32x4*)(rowp + (isv ? bj * HALF : bj * 2 * 256 * 64)) = w;
                    if (isv) { sa += (v0[0] + v0[1]) + (v0[2] + v0[3]) + (v1[0] + v1[1]) + (v1[2] + v1[3]);
                        sb += (v0[0] * v0[0] + v0[1] * v0[1]) + (v0[2] * v0[2] + v0[3] * v0[3]) + (v1[0] * v1[0] + v1[1] * v1[1]) + (v1[2] * v1[2] + v1[3] * v1[3]);
 } }
                if (isv) { sa += SHX(sa, 16); sa += SHX(sa, 32); sb += SHX(sb, 16); sb += SHX(sb, 32);
                    if (fq == 0) *(f32x2*)(vstat + (size_t)(row0 + ai * HALF + m * 16) * 96 + (pv * 4 + wc) * 2) = (f32x2){sa, sb}; }
            }
    }
};

struct EpiRes {
    static constexpr bool NEEDS_RS = false;
    const float* base_f; bf16_t* XB; float* ssq; const float* bias; bool dry;
    __device__ __forceinline__ void prep(const Unit&, LAS float*, int) const {}
    __device__ __forceinline__ void operator()(f32x4 (&acc)[2][2][4][2], const Unit& u, int wr, int wc, int fr, int fq, const LAS float*) const { const int lane = fq * 16 + fr; (void)lane;
        const int row0 = u.pm * BM + wr * 64 + fr, col0 = u.pn * BM + wc * 32 + 8 * fq;
        f32x4 bv[2][2];
#pragma unroll
        for (int bj = 0; bj < 2; ++bj)
#pragma unroll
            for (int n = 0; n < 2; ++n) bv[bj][n] = bias ? *(const f32x4*)(bias + col0 + bj * HALF + 4 * n) : (f32x4){0.f, 0.f, 0.f, 0.f};
#pragma unroll
        for (int ai = 0; ai < 2; ++ai)
#pragma unroll
            for (int m = 0; m < 4; ++m) { const int rl = ai * HALF + m * 16; const size_t ro = (size_t)(row0 + rl) * D + col0; float qs = 0.f;
#pragma unroll
                for (int bj = 0; bj < 2; ++bj) { f32x4 b0, b1;
                    if (base_f) { b0 = *(const f32x4*)(base_f + ro + bj * HALF); b1 = *(const f32x4*)(base_f + ro + bj * HALF + 4); }
                    else { const u32x4 t = *(const u32x4*)(XB + ro + bj * HALF); b0 = (f32x4){bf_lo(t.x), bf_hi(t.x), bf_lo(t.y), bf_hi(t.y)}; b1 = (f32x4){bf_lo(t.z), bf_hi(t.z), bf_lo(t.w), bf_hi(t.w)}; }
                    const f32x4 x0 = b0 + acc[ai][bj][m][0] + bv[bj][0], x1 = b1 + acc[ai][bj][m][1] + bv[bj][1];
                    u32x4 w; w.x = cvt_pk_bf16(x0[0], x0[1]); w.y = cvt_pk_bf16(x0[2], x0[3]); w.z = cvt_pk_bf16(x1[0], x1[1]); w.w = cvt_pk_bf16(x1[2], x1[3]);
                    if (!(PROBE_MASK && dry)) *(u32x4*)(XB + ro + bj * HALF) = w;
                    qs += (x0[0] * x0[0] + x0[1] * x0[1]) + (x0[2] * x0[2] + x0[3] * x0[3]) + (x1[0] * x1[0] + x1[1] * x1[1]) + (x1[2] * x1[2] + x1[3] * x1[3]); }
                qs += SHX(qs, 16); qs += SHX(qs, 32);
                if (fq == 0) ssq[(size_t)(row0 + rl) * 16 + u.pn * 4 + wc] = qs;
                asm volatile("" ::: "memory"); }
    }
};

struct EpiGU {
    static constexpr bool NEEDS_RS = true;
    bf16_t* H; const float* ssq; const float* ssqs;
    __device__ __forceinline__ void prep(const Unit& u, LAS float* tab, int tid) const {
        if (u.pm < MP / BM) rs_prep(ssq, u, tab, tid);
        else { const f32x4* p = (const f32x4*)(ssqs + (size_t)tid * 32); f32x4 a = p[0];
#pragma unroll
            for (int k = 1; k < 8; ++k) a += p[k];
            VM_WAIT(); tab[tid] = 1.0f / sqrtf(((a.x + a.y) + (a.z + a.w)) * (1.0f / D) + RMS_EPS); } }
    __device__ __forceinline__ void operator()(f32x4 (&acc)[2][2][4][2], const Unit& u, int wr, int wc, int fr, int fq, const LAS float* tab) const { const int lane = fq * 16 + fr; (void)lane;
        const int row0 = u.pm * BM + wr * 64 + fr, col0 = u.pn * HALF + wc * 32 + 8 * fq;
#pragma unroll
        for (int ai = 0; ai < 2; ++ai)
#pragma unroll
            for (int m = 0; m < 4; ++m) { const float rs = tab[ai * HALF + wr * 64 + m * 16 + fr];
                f32x4 h[2];
#pragma unroll
                for (int n = 0; n < 2; ++n) { const f32x4 gg = acc[ai][0][m][n] * rs, uu = acc[ai][1][m][n] * rs; h[n] = gg * sigmoid4(gg) * uu; }
                u32x4 w; w.x = cvt_pk_bf16(h[0][0], h[0][1]); w.y = cvt_pk_bf16(h[0][2], h[0][3]); w.z = cvt_pk_bf16(h[1][0], h[1][1]); w.w = cvt_pk_bf16(h[1][2], h[1][3]);
                *(u32x4*)(H + blk_off(row0 + ai * HALF + m * 16, col0, DFF / 64)) = w; }
    }
};

struct EpiGLU {
    static constexpr bool NEEDS_RS = true;
    bf16_t* G; const float* ssq; const float* bias; float* out_cp;
    __device__ __forceinline__ void prep(const Unit& u, LAS float* tab, int tid) const { rs_prep(ssq, u, tab, tid); }
    __device__ __forceinline__ void operator()(f32x4 (&acc)[2][2][4][2], const Unit& u, int wr, int wc, int fr, int fq, const LAS float* tab) const { const int lane = fq * 16 + fr; (void)lane;
        const int row0 = u.pm * BM + wr * 64 + fr, col0 = u.pn * HALF + wc * 32 + 8 * fq;
        f32x4 ba[2], bg[2];
#pragma unroll
        for (int n = 0; n < 2; ++n) { ba[n] = *(const f32x4*)(bias + col0 + 4 * n); bg[n] = *(const f32x4*)(bias + D + col0 + 4 * n); }
#pragma unroll
        for (int ai = 0; ai < 2; ++ai)
#pragma unroll
            for (int m = 0; m < 4; ++m) { const float rs = tab[ai * HALF + wr * 64 + m * 16 + fr]; const int r = row0 + ai * HALF + m * 16;
                f32x4 o[2];
#pragma unroll
                for (int n = 0; n < 2; ++n) { const f32x4 a = acc[ai][0][m][n] * rs + ba[n], gt = acc[ai][1][m][n] * rs + bg[n];
                    o[n] = a * sigmoid4(gt); }
                u32x4 w; w.x = cvt_pk_bf16(o[0][0], o[0][1]); w.y = cvt_pk_bf16(o[0][2], o[0][3]); w.z = cvt_pk_bf16(o[1][0], o[1][1]); w.w = cvt_pk_bf16(o[1][2], o[1][3]);
                *(u32x4*)(G + (size_t)r * D + col0) = w;
                { const int t = r & 4095; if (t >= 4066) { float* dst = out_cp + ((size_t)(r >> 12) * 30 + (t - 4066)) * D + col0; *(f32x4*)dst = o[0]; *(f32x4*)(dst + 4) = o[1]; } }
            }
    }
};
}

namespace thin {
template <int NF, bool ABLK = false>
__device__ __forceinline__ void unit_mma(const bf16_t* Abase, int arow, int K, const bf16_t* const (&B)[NF], int tid, int wave, int lane, LAS unsigned char* lds, f32x4 (&red)[NF]) {
    f32x4 acc[2][NF];
#pragma unroll
    for (int m = 0; m < 2; ++m)
#pragma unroll
        for (int n = 0; n < NF; ++n) acc[m][n] = (f32x4){0.f, 0.f, 0.f, 0.f};
    const int kw = K >> 3, nks = kw >> 5, kb = wave * kw;
    constexpr int CH = (NF == 2) ? 12 : 4;
    for (int k0 = 0; k0 < nks; k0 += CH) {
        bf16x8 a[2][CH], b[NF][CH];
#pragma unroll
        for (int s = 0; s < CH; ++s) if (k0 + s < nks) {
#pragma unroll
            for (int m = 0; m < 2; ++m) { const int kk = kb + 32 * (k0 + s) + 8 * (lane >> 4);
                a[m][s] = *(const bf16x8*)(ABLK ? Abase + blk_off(arow + 16 * m, kk, K >> 6) : Abase + (size_t)(arow + 16 * m) * K + kk); }
#pragma unroll
            for (int n = 0; n < NF; ++n) b[n][s] = *(const bf16x8*)(B[n] + kb + 32 * (k0 + s)); }
#pragma unroll
        for (int s = 0; s < CH; ++s) if (k0 + s < nks) {
#pragma unroll
            for (int m = 0; m < 2; ++m)
#pragma unroll
                for (int n = 0; n < NF; ++n) acc[m][n] = __builtin_amdgcn_mfma_f32_16x16x32_bf16(b[n][s], a[m][s], acc[m][n], 0, 0, 0); }
    }
    __syncthreads();
    LAS f32x4* P = (LAS f32x4*)lds;
#pragma unroll
    for (int m = 0; m < 2; ++m)
#pragma unroll
        for (int n = 0; n < NF; ++n) P[(wave * 2 * NF + m * NF + n) * 64 + lane] = acc[m][n];
    __syncthreads();
    if (tid < 128) { const int m = tid >> 6;
#pragma unroll
        for (int n = 0; n < NF; ++n) { f32x4 s = P[(m * NF + n) * 64 + lane];
#pragma unroll
            for (int w = 1; w < 8; ++w) s += P[(w * 2 * NF + m * NF + n) * 64 + lane];
            red[n] = s; } }
}
__device__ __forceinline__ float rs_of(const float* ssqs, int r) {
    const f32x4* p = (const f32x4*)(ssqs + (size_t)r * 32); f32x4 a = p[0];
#pragma unroll
    for (int k = 1; k < 8; ++k) a += p[k];
    return 1.0f / sqrtf(((a.x + a.y) + (a.z + a.w)) * (1.0f / D) + RMS_EPS);
}
__device__ __forceinline__ u32x2 pk4(f32x4 v) { u32x2 w; w.x = cvt_pk_bf16(v[0], v[1]); w.y = cvt_pk_bf16(v[2], v[3]); return w; }

__device__ __forceinline__ int xcd_unit(int t, int G, int per) {
    if (G != 256) return t;
    const int x = t & 7, q = (t & 255) >> 3, i = t >> 8, l = q * per + i;
    return ((x + 8 * (l >> 3)) << 3) | (l & 7);
}
__device__ __forceinline__ void t_in(int unit, int tid, int wave, int lane, LAS unsigned char* lds, const bf16_t* XB, const bf16_t* W, const float* bias, const float* ssqs, bf16_t* U, bf16_t* V, float* vstat, float* vraw) {
    const int fr = lane & 15, fq = lane >> 4, s = unit & 7, cb = unit >> 3, c0 = 64 * cb;
    const bf16_t* const B[4] = {W + (size_t)(c0 + fr) * D + 8 * fq, W + (size_t)(c0 + 16 + fr) * D + 8 * fq, W + (size_t)(c0 + 32 + fr) * D + 8 * fq, W + (size_t)(c0 + 48 + fr) * D + 8 * fq};
    const int r = 32 * s + 16 * ((tid >> 6) & 1) + fr; float rs = 0.f; f32x4 bv[4];
    if (tid < 128) { rs = rs_of(ssqs, r);
#pragma unroll
        for (int n = 0; n < 4; ++n) bv[n] = *(const f32x4*)(bias + c0 + 16 * n + 4 * fq); }
    f32x4 red[4]; unit_mma<4>(XB, MP + 32 * s + fr, D, B, tid, wave, lane, lds, red);
    if (tid < 128) { const bool isv = (cb >= 48); const int oc = (isv ? c0 - DSGU : c0) + 4 * fq; bf16_t* O = isv ? V : U;
        float sa = 0.f, sb = 0.f;
#pragma unroll
        for (int n = 0; n < 4; ++n) { f32x4 v = red[n] * rs + bv[n];
#pragma unroll
            for (int j = 0; j < 4; ++j) v[j] = gelu_tanh(v[j]);
            *(u32x2*)(isv ? O + (size_t)(MP + r) * DSGU + oc + 16 * n : O + blk_off(MP + r, oc + 16 * n, DSGU / 64)) = pk4(v);
            if (isv) { *(f32x4*)(vraw + (size_t)r * DSGU + oc + 16 * n) = v; sa += (v[0] + v[1]) + (v[2] + v[3]); sb += (v[0] * v[0] + v[1] * v[1]) + (v[2] * v[2] + v[3] * v[3]); } }
        if (isv) { sa += SHX(sa, 16); sa += SHX(sa, 32); sb += SHX(sb, 16); sb += SHX(sb, 32);
            if (fq == 0) *(f32x2*)(vstat + (size_t)(MP + r) * 96 + (cb - 48) * 2) = (f32x2){sa, sb}; } }
}
__device__ __forceinline__ void t_in_unit(const bf16x8 (&a)[2][4], const bf16x8 (&bb)[4][4], int s, int cb, float rs, int tid, int wave, int lane, LAS unsigned char* lds, const float* bias, bf16_t* U, bf16_t* V, float* vstat, float* vraw) {
    const int fr = lane & 15, fq = lane >> 4, c0 = 64 * cb, r = 32 * s + 16 * ((tid >> 6) & 1) + fr; f32x4 bv[4];
    if (tid < 128) {
#pragma unroll
        for (int n = 0; n < 4; ++n) bv[n] = *(const f32x4*)(bias + c0 + 16 * n + 4 * fq); }
    f32x4 acc[2][4];
#pragma unroll
    for (int m = 0; m < 2; ++m)
#pragma unroll
        for (int n = 0; n < 4; ++n) acc[m][n] = (f32x4){0.f, 0.f, 0.f, 0.f};
#pragma unroll
    for (int ks = 0; ks < 4; ++ks)
#pragma unroll
        for (int m = 0; m < 2; ++m)
#pragma unroll
            for (int n = 0; n < 4; ++n) acc[m][n] = __builtin_amdgcn_mfma_f32_16x16x32_bf16(bb[n][ks], a[m][ks], acc[m][n], 0, 0, 0);
    __syncthreads();
    LAS f32x4* P = (LAS f32x4*)lds;
#pragma unroll
    for (int m = 0; m < 2; ++m)
#pragma unroll
        for (int n = 0; n < 4; ++n) P[(wave * 8 + m * 4 + n) * 64 + lane] = acc[m][n];
    __syncthreads();
    if (tid < 128) { const int m = tid >> 6; const bool isv = (cb >= 48); const int oc = (isv ? c0 - DSGU : c0) + 4 * fq; bf16_t* O = isv ? V : U;
        float sa = 0.f, sb = 0.f;
#pragma unroll
        for (int n = 0; n < 4; ++n) { f32x4 v = P[(m * 4 + n) * 64 + lane];
#pragma unroll
            for (int w = 1; w < 8; ++w) v += P[(w * 8 + m * 4 + n) * 64 + lane];
            v = v * rs + bv[n];
#pragma unroll
            for (int j = 0; j < 4; ++j) v[j] = gelu_tanh(v[j]);
            *(u32x2*)(isv ? O + (size_t)(MP + r) * DSGU + oc + 16 * n : O + blk_off(MP + r, oc + 16 * n, DSGU / 64)) = pk4(v);
            if (isv) { *(f32x4*)(vraw + (size_t)r * DSGU + oc + 16 * n) = v; sa += (v[0] + v[1]) + (v[2] + v[3]); sb += (v[0] * v[0] + v[1] * v[1]) + (v[2] * v[2] + v[3] * v[3]); } }
        if (isv) { sa += SHX(sa, 16); sa += SHX(sa, 32); sb += SHX(sb, 16); sb += SHX(sb, 32);
            if (fq == 0) *(f32x2*)(vstat + (size_t)(MP + r) * 96 + (cb - 48) * 2) = (f32x2){sa, sb}; } }
}
#define T_IN_LOADB(dst, cb_) _Pragma("unroll") for (int n = 0; n < 4; ++n) _Pragma("unroll") for (int ks = 0; ks < 4; ++ks) dst[n][ks] = *(const bf16x8*)(W + (size_t)(64 * (cb_) + 16 * n + fr) * D + kq + 32 * ks)
__device__ __forceinline__ void t_in3(int b, int tid, int wave, int lane, LAS unsigned char* lds, const bf16_t* XB, const bf16_t* W, const float* bias, const float* ssqs, bf16_t* U, bf16_t* V, float* vstat, float* vraw) {
    const int fr = lane & 15, fq = lane >> 4, s = b & 7, cbA = b >> 3, kq = wave * 128 + 8 * fq;
    bf16x8 a[2][4], b0[4][4], b1[4][4];
#pragma unroll
    for (int m = 0; m < 2; ++m)
#pragma unroll
        for (int ks = 0; ks < 4; ++ks) a[m][ks] = *(const bf16x8*)(XB + (size_t)(MP + 32 * s + 16 * m + fr) * D + kq + 32 * ks);
    T_IN_LOADB(b0, cbA); T_IN_LOADB(b1, cbA + 32);
    const float rs = (tid < 128) ? rs_of(ssqs, 32 * s + 16 * ((tid >> 6) & 1) + fr) : 0.f;
    t_in_unit(a, b0, s, cbA, rs, tid, wave, lane, lds, bias, U, V, vstat, vraw);
    T_IN_LOADB(b0, cbA + 64);
    t_in_unit(a, b1, s, cbA + 32, rs, tid, wave, lane, lds, bias, U, V, vstat, vraw);
    t_in_unit(a, b0, s, cbA + 64, rs, tid, wave, lane, lds, bias, U, V, vstat, vraw);
}
#undef T_IN_LOADB
__device__ __forceinline__ void t_res(int unit, int tid, int wave, int lane, LAS unsigned char* lds, const bf16_t* A, int K, const bf16_t* W, const float* bias, const float* base_f, bf16_t* XB, float* ssqs_out, bool dry, bool ablk) {
    const int fr = lane & 15, fq = lane >> 4, s = unit & 7, cb = unit >> 3, c0 = 32 * cb;
    const bf16_t* const B[2] = {W + (size_t)(c0 + fr) * K + 8 * fq, W + (size_t)(c0 + 16 + fr) * K + 8 * fq};
    const int r = 32 * s + 16 * ((tid >> 6) & 1) + fr; f32x4 xb[2];
    if (tid < 128) {
#pragma unroll
        for (int n = 0; n < 2; ++n) { const int c = c0 + 16 * n + 4 * fq;
            if (base_f) xb[n] = *(const f32x4*)(base_f + (size_t)r * D + c);
            else { const u32x2 t = *(const u32x2*)(XB + (size_t)(MP + r) * D + c); xb[n] = (f32x4){bf_lo(t.x), bf_hi(t.x), bf_lo(t.y), bf_hi(t.y)}; }
            if (bias) xb[n] += *(const f32x4*)(bias + c); } }
    f32x4 red[2]; if (ablk) unit_mma<2, true>(A, MP + 32 * s + fr, K, B, tid, wave, lane, lds, red); else unit_mma<2, false>(A, MP + 32 * s + fr, K, B, tid, wave, lane, lds, red);
    if (tid < 128) { float q = 0.f;
#pragma unroll
        for (int n = 0; n < 2; ++n) { const int c = c0 + 16 * n + 4 * fq; f32x4 x = xb[n] + red[n];
            if (!(PROBE_MASK && dry)) *(u32x2*)(XB + (size_t)(MP + r) * D + c) = pk4(x);
            q += (x[0] * x[0] + x[1] * x[1]) + (x[2] * x[2] + x[3] * x[3]); }
        q += SHX(q, 16); q += SHX(q, 32);
        if (fq == 0) ssqs_out[(size_t)r * 32 + cb] = q; }
}
__device__ __forceinline__ void t_gu(int unit, int tid, int wave, int lane, LAS unsigned char* lds, const bf16_t* XB, const bf16_t* W, const float* ssqs, bf16_t* H) {
    const int fr = lane & 15, fq = lane >> 4, s = unit & 7, hb = unit >> 3, h0 = 32 * hb, wrow = 256 * (h0 >> 7) + (h0 & 127) + fr;
    const bf16_t* const B[4] = {W + (size_t)wrow * D + 8 * fq, W + (size_t)(wrow + 16) * D + 8 * fq, W + (size_t)(wrow + 128) * D + 8 * fq, W + (size_t)(wrow + 144) * D + 8 * fq};
    f32x4 red[4]; unit_mma<4>(XB, MP + 32 * s + fr, D, B, tid, wave, lane, lds, red);
    if (tid < 128) { const int r = 32 * s + 16 * (tid >> 6) + fr; const float rs = rs_of(ssqs, r);
#pragma unroll
        for (int n = 0; n < 2; ++n) { f32x4 h;
#pragma unroll
            for (int j = 0; j < 4; ++j) { const float gg = red[n][j] * rs, uu = red[n + 2][j] * rs; h[j] = gg * sigmoid_f(gg) * uu; }
            *(u32x2*)(H + (size_t)(MP + r) * DFF + h0 + 16 * n + 4 * fq) = pk4(h); } }
}
__device__ __forceinline__ void t_glu(int unit, int tid, int wave, int lane, LAS unsigned char* lds, const bf16_t* XB, const bf16_t* W, const float* bias, const float* ssqs, bf16_t* G, float* out_cs) {
    const int fr = lane & 15, fq = lane >> 4, s = unit & 7, cb = unit >> 3, c0 = 32 * cb, wrow = 256 * (c0 >> 7) + (c0 & 127) + fr;
    const bf16_t* const B[4] = {W + (size_t)wrow * D + 8 * fq, W + (size_t)(wrow + 16) * D + 8 * fq, W + (size_t)(wrow + 128) * D + 8 * fq, W + (size_t)(wrow + 144) * D + 8 * fq};
    const int r = 32 * s + 16 * ((tid >> 6) & 1) + fr; float rs = 0.f; f32x4 bv[4];
    if (tid < 128) { rs = rs_of(ssqs, r);
#pragma unroll
        for (int n = 0; n < 2; ++n) { bv[n] = *(const f32x4*)(bias + c0 + 16 * n + 4 * fq); bv[n + 2] = *(const f32x4*)(bias + D + c0 + 16 * n + 4 * fq); } }
    f32x4 red[4]; unit_mma<4>(XB, MP + 32 * s + fr, D, B, tid, wave, lane, lds, red);
    if (tid < 128) { const int tt = r & 31;
#pragma unroll
        for (int n = 0; n < 2; ++n) { const int c = c0 + 16 * n + 4 * fq; const f32x4 a = red[n] * rs + bv[n], gt = red[n + 2] * rs + bv[n + 2]; f32x4 o;
#pragma unroll
            for (int j = 0; j < 4; ++j) o[j] = a[j] * sigmoid_f(gt[j]);
            *(u32x2*)(G + (size_t)(MP + r) * D + c) = pk4(o);
            if (tt >= 2) *(f32x4*)(out_cs + ((size_t)(r >> 5) * 30 + (tt - 2)) * D + c) = o; } }
}
}

#define XB_TMO      128
#define XB_XCNT(j)  (256  + 64 * (j))
#define XB_XSUB(j)  (1280 + 64 * (j))
#define XB_XGEN(j)  (2304 + 64 * (j))
#define XB_TOP      3328
#define XB_TOPGEN   3392
#define XCD_BAR_WORDS 3456
#define XB_SPIN_CAP (1u << 18)
__device__ __forceinline__ unsigned xb_ld(unsigned* p)              { return __hip_atomic_load(p, __ATOMIC_RELAXED, __HIP_MEMORY_SCOPE_AGENT); }
__device__ __forceinline__ unsigned xb_add(unsigned* p, unsigned v) { return __hip_atomic_fetch_add(p, v, __ATOMIC_RELAXED, __HIP_MEMORY_SCOPE_AGENT); }
__device__ __forceinline__ unsigned xb_xcc_id() { return (unsigned)__builtin_amdgcn_s_getreg((3 << 11) | 20) & 0xFu; }
#define XB_SPIN(cond, bar) do { unsigned _sp = 0; while (cond) { __builtin_amdgcn_s_sleep(1); \
    if ((++_sp & 255u) == 0u) { if (xb_ld(&(bar)[XB_TMO])) break; if (_sp > XB_SPIN_CAP) { atomicAdd(&(bar)[XB_TMO], 1u); break; } } } } while (0)
struct XcdBarrier { unsigned* bar; unsigned x; volatile LAS unsigned* st; };
__device__ __forceinline__ XcdBarrier xcd_barrier_post(unsigned* bar, volatile LAS unsigned* st) {
    XcdBarrier b; b.bar = bar; b.x = xb_xcc_id(); b.st = st;
    if (threadIdx.x == 0) (void)xb_add(&bar[XB_XCNT(b.x)], 1u);
    return b;
}
__device__ __forceinline__ void xcd_barrier_complete(unsigned* bar, unsigned x, unsigned& nloc, unsigned& nx) {
    const unsigned G = gridDim.x * gridDim.y * gridDim.z;
    unsigned sum, cnt, mine, sp = 0u;
    for (;;) {
        sum = 0u; cnt = 0u; mine = 0u;
#pragma unroll
        for (unsigned j = 0; j < 16; ++j) { const unsigned c = xb_ld(&bar[XB_XCNT(j)]); sum += c; cnt += (c > 0u) ? 1u : 0u; mine = (j == x) ? c : mine; }
        if (sum == G) break;
        __builtin_amdgcn_s_sleep(1);
        if ((++sp & 255u) == 0u) { if (xb_ld(&bar[XB_TMO])) break; if (sp > XB_SPIN_CAP) { atomicAdd(&bar[XB_TMO], 1u); break; } }
    }
    nloc = mine > 0u ? mine : 1u; nx = cnt > 0u ? cnt : 1u;
}
__device__ __forceinline__ void xcd_barrier(const XcdBarrier& b) {
    asm volatile("s_waitcnt vmcnt(0)" ::: "memory");
    __syncthreads();
    if (threadIdx.x == 0) {
        unsigned long long bar_i = (unsigned long long)b.bar; asm volatile("" : "+v"(bar_i)); unsigned* bar = (unsigned*)(GAS unsigned*)bar_i;
        __builtin_amdgcn_s_waitcnt(0);
        unsigned nloc = b.st[0], nx = b.st[1];
        if (nloc == 0u) { xcd_barrier_complete(bar, b.x, nloc, nx); b.st[0] = nloc; b.st[1] = nx; }
        const unsigned old = xb_add(&bar[XB_XSUB(b.x)], 1u);
        const unsigned gen = old / nloc;
        if (old + 1u == (gen + 1u) * nloc) {
            __builtin_amdgcn_fence(__ATOMIC_RELEASE, "agent");
            asm volatile("s_waitcnt vmcnt(0)" ::: "memory");
            const unsigned og = xb_add(&bar[XB_TOP], 1u);
            const unsigned tg = og / nx;
            if (og + 1u == (tg + 1u) * nx) xb_add(&bar[XB_TOPGEN], 1u);
            else XB_SPIN(xb_ld(&bar[XB_TOPGEN]) == tg, bar);
            xb_add(&bar[XB_XGEN(b.x)], 1u);
            __builtin_amdgcn_fence(__ATOMIC_ACQUIRE, "agent");
            asm volatile("s_waitcnt vmcnt(0)" ::: "memory");
        } else {
            XB_SPIN(xb_ld(&bar[XB_XGEN(b.x)]) == gen, bar);
            __builtin_amdgcn_fence(__ATOMIC_ACQUIRE, "agent");
            asm volatile("s_waitcnt vmcnt(0)" ::: "memory");
        }
    }
    __syncthreads();
}

struct Args { const float* in[25]; float* out; unsigned char* ws; int ph_lo, ph_hi, li, pad; };
enum { I_XP = 0, I_XS, I_STATE, I_GMIX, I_GFFN, I_GFIN, I_WIN, I_BIN, I_LNG, I_LNB, I_WS, I_BS, I_WOUT, I_BOUT, I_PW1, I_BPW1, I_WDW, I_BDW, I_CLNG, I_CLNB, I_PW2, I_BPW2, I_WG, I_WU, I_WD };

__device__ __forceinline__ void cvt_item(const float* W, int K, int N, const float* gsc, bf16_t* WT, int kind, LAS float* scr, int item, int lane) {
    const int nblk = N / 32, kb = item / nblk, nb = item % nblk, k0 = 64 * kb, n0 = 32 * nb;
    int row0 = n0;
    if (kind == 1) row0 = 256 * (n0 >> 7) + (n0 & 127);
    else if (kind == 2) row0 = 256 * (n0 >> 7) + (n0 & 127) + 128;
    else if (kind == 3) { const int n1 = n0 & 1023; row0 = 256 * (n1 >> 7) + (n1 & 127) + ((n0 >= 1024) ? 128 : 0); }
    float wv[32];
#pragma unroll
    for (int i = 0; i < 32; ++i) wv[i] = __builtin_nontemporal_load(&W[(size_t)(k0 + 2 * i + (lane >> 5)) * N + n0 + (lane & 31)]);
    if (gsc) {
#pragma unroll
        for (int i = 0; i < 32; ++i) wv[i] *= gsc[k0 + 2 * i + (lane >> 5)]; }
#pragma unroll
    for (int i = 0; i < 32; ++i) scr[(2 * i + (lane >> 5)) * 33 + (lane & 31)] = wv[i];
    LDS_WAIT(); asm volatile("" ::: "memory");
    const int c = lane & 7;
#pragma unroll
    for (int j = 0; j < 4; ++j) { const int n = (lane >> 3) + 8 * j; const LAS float* s = scr + (8 * c) * 33 + n;
        u32x4 o; o.x = pk2(s[0 * 33], s[1 * 33]); o.y = pk2(s[2 * 33], s[3 * 33]); o.z = pk2(s[4 * 33], s[5 * 33]); o.w = pk2(s[6 * 33], s[7 * 33]);
        *(u32x4*)(WT + (size_t)(row0 + n) * K + k0 + 8 * c) = o; }
    LDS_WAIT(); asm volatile("" ::: "memory");
}
__device__ __forceinline__ void convert_layer(int L, LAS unsigned char* lds, int gw, int NGW, int wave, int lane) {
    LAS float* scr = (LAS float*)(lds + wave * 16384);
    const int j = L >> 1; const bool sgu = !(L & 1);
    unsigned char* slot = KWS() + (sgu ? WS_SLOTA : WS_SLOTB);
    const float* w0 = sgu ? KIN(I_WIN) + (size_t)j * D * DSF : KIN(I_PW1) + (size_t)j * D * 2 * D;
    const float* w1 = sgu ? KIN(I_WOUT) + (size_t)j * DSGU * D : KIN(I_PW2) + (size_t)j * D * D;
    const int N0 = sgu ? DSF : 2 * D, K1 = sgu ? DSGU : D;
    const int I0 = (D / 64) * (N0 / 32), I1 = (K1 / 64) * (D / 32), IG = (D / 64) * (DFF / 32), ID = (DFF / 64) * (D / 32);
    bf16_t* d0 = (bf16_t*)(slot + (sgu ? SA_WIN : SB_PW1)); bf16_t* d1 = (bf16_t*)(slot + (sgu ? SA_WOUT : SB_PW2));
    bf16_t* dg = (bf16_t*)(slot + (sgu ? SA_WGU : SB_WGU)); bf16_t* dd = (bf16_t*)(slot + (sgu ? SA_WDN : SB_WDN));
    const float* gmix = KIN(I_GMIX) + L * D; const float* gffn = KIN(I_GFFN) + L * D;
    const int total = I0 + I1 + 2 * IG + ID;
    for (int it = gw; it < total; it += NGW) {
        int r = it; asm volatile("" : "+v"(r));
        if (r < I0) { cvt_item(w0, D, N0, gmix, d0, sgu ? 0 : 3, scr, r, lane); continue; } r -= I0;
        if (r < I1) { cvt_item(w1, K1, D, nullptr, d1, 0, scr, r, lane); continue; } r -= I1;
        if (r < IG) { cvt_item(KIN(I_WG) + (size_t)L * D * DFF, D, DFF, gffn, dg, 1, scr, r, lane); continue; } r -= IG;
        if (r < IG) { cvt_item(KIN(I_WU) + (size_t)L * D * DFF, D, DFF, gffn, dg, 2, scr, r, lane); continue; } r -= IG;
        cvt_item(KIN(I_WD) + (size_t)L * DFF * D, DFF, D, nullptr, dd, 0, scr, r, lane);
    }
    __syncthreads();
}

__device__ __forceinline__ void p0_rows(int gw, int NGW, int lane) {
    unsigned char* ws = KWS(); bf16_t* XB = (bf16_t*)(ws + WS_XB); float* ssq = (float*)(ws + WS_SSQA); float* ssqs = (float*)(ws + WS_SSQSA);
    for (int m = gw; m < M; m += NGW) {
        const float* xrow = (m < MP) ? KIN(I_XP) + (size_t)m * D : KIN(I_XS) + (size_t)(m - MP) * D;
        const f32x4* xr = (const f32x4*)xrow + lane; f32x4 v[4]; float s = 0.f;
#pragma unroll
        for (int jj = 0; jj < 4; ++jj) { v[jj] = __builtin_nontemporal_load(xr + 64 * jj); s += (v[jj].x * v[jj].x + v[jj].y * v[jj].y) + (v[jj].z * v[jj].z + v[jj].w * v[jj].w); }
        s = wave_sum(s, lane);
        u32x2* o8 = (u32x2*)(XB + (size_t)m * D) + lane;
#pragma unroll
        for (int jj = 0; jj < 4; ++jj) { u32x2 w; w.x = pk2(v[jj].x, v[jj].y); w.y = pk2(v[jj].z, v[jj].w); o8[64 * jj] = w; }
        if (m < MP) { if (lane < 16) ssq[(size_t)m * 16 + lane] = (lane == 0) ? s : 0.f; }
        else if (lane < 32) ssqs[(size_t)(m - MP) * 32 + lane] = (lane == 0) ? s : 0.f;
    }
}

__device__ __forceinline__ void final_rows(int gw, int NGW, int lane, bool dry) {
    float* Y = KOUT(); unsigned char* ws = KWS(); const bf16_t* XB = (const bf16_t*)(ws + WS_XB); const float* ssq = (const float*)(ws + WS_SSQA); const float* ssqs = (const float*)(ws + WS_SSQSA); const float* gf = KIN(I_GFIN);
    f32x4 gv[4];
#pragma unroll
    for (int jj = 0; jj < 4; ++jj) gv[jj] = ((const f32x4*)gf)[lane + 64 * jj];
    for (int m = gw; m < M; m += NGW) {
        const float p = (m < MP) ? ((lane < 16) ? ssq[(size_t)m * 16 + lane] : 0.f) : ((lane < 32) ? ssqs[(size_t)(m - MP) * 32 + lane] : 0.f);
        const u32x2* xr = (const u32x2*)(XB + (size_t)m * D) + lane; u32x2 t[4];
#pragma unroll
        for (int jj = 0; jj < 4; ++jj) t[jj] = __builtin_nontemporal_load(xr + 64 * jj);
        const float s = wave_sum(p, lane); const float rs = 1.0f / sqrtf(s * (1.0f / D) + RMS_EPS);
        f32x4* yr = (f32x4*)(Y + (size_t)m * D) + lane;
#pragma unroll
        for (int jj = 0; jj < 4; ++jj) { const f32x4 v = (f32x4){bf_lo(t[jj].x), bf_hi(t[jj].x), bf_lo(t[jj].y), bf_hi(t[jj].y)}; if (!(PROBE_MASK && dry)) __builtin_nontemporal_store(v * rs * gv[jj], yr + 64 * jj); }
    }
}

__device__ __forceinline__ void sample_v_rows(int j, int gw, int NGW, int lane, bool dry) {
    float* vr = KOUT() + O_SV + (size_t)j * MS * DSGU; const float* vstat = (const float*)(KWS() + WS_VSTAT);
    const float* g = KIN(I_LNG) + j * DSGU; const float* b = KIN(I_LNB) + j * DSGU;
    for (int r = gw; r < MS; r += NGW) {
        float s = 0.f, q = 0.f;
        if (lane < 48) { const f32x2 p = *(const f32x2*)(vstat + (size_t)(MP + r) * 96 + lane * 2); s = p.x; q = p.y; }
        s = wave_sum(s, lane); q = wave_sum(q, lane);
        const float mean = s * (1.0f / DSGU), var = q * (1.0f / DSGU) - mean * mean, rstd = 1.0f / sqrtf(var + LN_EPS);
        f32x4* row = (f32x4*)(vr + (size_t)r * DSGU);
        for (int k = lane; k < DSGU / 4; k += 64) { const f32x4 v = row[k]; if (!(PROBE_MASK && dry)) row[k] = (v - mean) * rstd * ((const f32x4*)g)[k] + ((const f32x4*)b)[k]; }
    }
}

constexpr int MIX_ITEMS = 512 + 24;
constexpr int MIX_VS = 520;
constexpr int MIX_WP = 0, MIX_MU = 34816, MIX_RS = 35328, MIX_C1 = 35840, MIX_C2 = 36352, MIX_V = 36864;
constexpr int MIX_LG = MIX_V + 128 * MIX_VS, MIX_LB = MIX_LG + 3072;
constexpr int MIX_QW = MIX_LB + 3072 + 512;
constexpr int MIX_BSV = MIX_LB + 3072;
static_assert(MIX_QW + 8 <= RING_BYTES, "mix LDS map");
__device__ __forceinline__ void mix_decode(int item, int& c, int& hd, int& tb, int& te) {
    if (item < 512) { c = item >> 2; hd = item & 3; tb = 0; te = 3; } else { const int q = item - 512; c = 128 + q / 12; hd = (q % 12) / 3; tb = q % 3; te = tb + 1; }
}
#define MIX_LOAD_V(c_, hd_, t3_) _Pragma("unroll") for (int i = 0; i < 8; ++i) { const int p = tid + 512 * i, row = p >> 5, c16 = p & 31; vreg[i] = __builtin_nontemporal_load((const u32x4*)(V + (size_t)(128 * (c_) + row) * DSGU + 768 * (hd_) + 256 * (t3_) + 8 * c16)); }
#define MIX_LOAD_U(dst, c_, hd_, t3_) _Pragma("unroll") for (int mi = 0; mi < 8; ++mi) dst[mi] = *(const u32x4*)(U + blk_off(128 * (c_) + 16 * mi + fr, 768 * (hd_) + 256 * (t3_) + 32 * wave + 8 * fq, DSGU / 64))
__device__ __forceinline__ void mix_phase(int j, LAS unsigned char* lds, int tid, int wave, int lane, int c0, int G, bool dry) {
    const float* Wsl = KIN(I_WS) + (size_t)j * 4 * 128 * 128; const float* bs = KIN(I_BS) + j * 4 * 128;
    const float* lng = KIN(I_LNG) + j * DSGU; const float* lnb = KIN(I_LNB) + j * DSGU;
    unsigned char* ws = KWS();
    const float* vstat = (const float*)(ws + WS_VSTAT); bf16_t* U = (bf16_t*)(ws + WS_U); const bf16_t* V = (const bf16_t*)(ws + WS_V);
    LAS float* mu = (LAS float*)(lds + MIX_MU); LAS float* rsd = (LAS float*)(lds + MIX_RS); LAS float* c1 = (LAS float*)(lds + MIX_C1); LAS float* c2 = (LAS float*)(lds + MIX_C2);
    const int fr = lane & 15, fq = lane >> 4;
    unsigned* qctr = (unsigned*)(ws + WS_CTL) + CW_BAR + 32 + 32 * j;
    volatile LAS int* QW = (volatile LAS int*)(lds + MIX_QW);
    int item = c0, c, hd, tb, te; mix_decode(item, c, hd, tb, te); int t3 = tb; bool newitem = true, more = (item < MIX_ITEMS);
    int pend = -1, qp = 0; bool pend_valid = false, cis = false;
    if (tid == 0) { QW[0] = -1; QW[1] = -1; }
    u32x4 vreg[8], ureg[8];
    if (more) { MIX_LOAD_V(c, hd, t3); MIX_LOAD_U(ureg, c, hd, t3); }
    while (more) {
        const bool smp = (c >= 128);
        if (tid == 0 && pend_valid) { QW[qp] = G + pend; pend_valid = false; }
        __syncthreads();
        const int claimed = QW[qp];
        if (newitem) { const f32x4* p = (const f32x4*)(vstat + (size_t)(128 * c + (tid >> 2)) * 96 + (tid & 3) * 24); f32x4 sv[6];
#pragma unroll
            for (int k = 0; k < 6; ++k) sv[k] = p[k];
            float s = 0.f, q = 0.f;
#pragma unroll
            for (int k = 0; k < 6; ++k) { s += sv[k].x + sv[k].z; q += sv[k].y + sv[k].w; }
            s += SHX(s, 1); s += SHX(s, 2); q += SHX(q, 1); q += SHX(q, 2);
            if ((tid & 3) == 0) { const float mean = s * (1.0f / DSGU), var = q * (1.0f / DSGU) - mean * mean; mu[tid >> 2] = mean; rsd[tid >> 2] = 1.0f / sqrtf(var + LN_EPS); } }
#pragma unroll
        for (int i = 0; i < 8; ++i) { const int p = tid + 512 * i, row = p >> 5, c16 = p & 31;
            *(LAS u32x2*)(lds + MIX_V + row * MIX_VS + c16 * 16) = (u32x2){vreg[i].x, vreg[i].y}; *(LAS u32x2*)(lds + MIX_V + row * MIX_VS + c16 * 16 + 8) = (u32x2){vreg[i].z, vreg[i].w}; }
        int nitem = item, nc = c, nhd = hd, ntb = tb, nte = te, nt3 = t3 + 1; bool nknown = true;
        const bool ends = (nt3 >= te);
        if (ends) { if (claimed >= 0) { nitem = claimed; mix_decode(nitem, nc, nhd, ntb, nte); nt3 = ntb; } else nknown = false; }
        const bool nmore = nknown && (nitem < MIX_ITEMS);
        if (!nmore) { nc = c; nhd = hd; nt3 = t3; }
        if (nmore && !newitem) { MIX_LOAD_V(nc, nhd, nt3); }
        if (!cis && te - t3 <= 2) { cis = true; if (tid == 0) { pend = (int)__builtin_amdgcn_atomic_inc32(qctr, 0xFFFFFFFFu, __ATOMIC_RELAXED, "agent"); pend_valid = true; } }
        __syncthreads();
        if (newitem) { const int i = tid >> 2, jq = tid & 3, j0 = jq * 32; const int ii = smp ? (i & 31) : i;
          const float* wrow = Wsl + ((size_t)hd * 128 + ii) * 128 + (smp ? 0 : j0);
          const int lim = smp ? ((jq == (i >> 5)) ? ii : -1) : (i - j0);
          float c1p = 0.f, c2p = 0.f; f32x4 wq[8];
#pragma unroll
          for (int k = 0; k < 8; ++k) wq[k] = *(const f32x4*)(wrow + 4 * k);
#pragma unroll
          for (int jj = 0; jj < 32; jj += 8) { const f32x4 wa = wq[jj >> 2], wb = wq[(jj >> 2) + 1]; const float wv[8] = {wa.x, wa.y, wa.z, wa.w, wb.x, wb.y, wb.z, wb.w}; unsigned hw[8];
#pragma unroll
              for (int e = 0; e < 8; ++e) { const float w = (jj + e <= lim) ? wv[e] : 0.f; c2p += w; hw[e] = f2bf(w * rsd[j0 + jj + e]); c1p += __builtin_bit_cast(float, hw[e] << 16) * mu[j0 + jj + e]; }
              *(LAS u32x4*)(lds + MIX_WP + i * 272 + (j0 + jj) * 2) = (u32x4){hw[0] | (hw[1] << 16), hw[2] | (hw[3] << 16), hw[4] | (hw[5] << 16), hw[6] | (hw[7] << 16)}; }
          c1p += SHX(c1p, 1); c1p += SHX(c1p, 2); c2p += SHX(c2p, 1); c2p += SHX(c2p, 2);
          if (jq == 0) { c1[i] = c1p; c2[i] = c2p; }
          if (tid < 192) *(LAS f32x4*)(lds + MIX_LG + tid * 16) = *(const f32x4*)(lng + 768 * hd + 4 * tid);
          else if (tid < 384) *(LAS f32x4*)(lds + MIX_LB + (tid - 192) * 16) = *(const f32x4*)(lnb + 768 * hd + 4 * (tid - 192));
          else { const int r = tid - 384; *(LAS float*)(lds + MIX_BSV + r * 4) = bs[hd * 128 + (smp ? (r & 31) : r)]; }
          __syncthreads();
          if (nmore) { MIX_LOAD_V(nc, nhd, nt3); } }
        {
            const int dcol = 768 * hd + 256 * t3, d0 = dcol + 32 * wave + 8 * fq;
            f32x4 acc[8][2];
#pragma unroll
            for (int mi = 0; mi < 8; ++mi) { acc[mi][0] = (f32x4){0.f, 0.f, 0.f, 0.f}; acc[mi][1] = (f32x4){0.f, 0.f, 0.f, 0.f}; }
#pragma unroll
            for (int ks = 0; ks < 4; ++ks) { bf16x8 Bf[2];
#pragma unroll
                for (int n = 0; n < 2; ++n) { const LAS unsigned char* vb = lds + MIX_V + (32 * wave + pg8::perm32(16 * n + fr)) * 2 + (8 * fq) * MIX_VS; u32x4 t;
#pragma unroll
                    for (int e = 0; e < 4; ++e) { const unsigned lo = *(const LAS unsigned short*)(vb + (32 * ks + 2 * e) * MIX_VS), hi = *(const LAS unsigned short*)(vb + (32 * ks + 2 * e + 1) * MIX_VS); t[e] = lo | (hi << 16); }
                    Bf[n] = __builtin_bit_cast(bf16x8, t); }
#pragma unroll
                for (int mi = 2 * ks; mi < 8; ++mi) { const bf16x8 Af = *(const LAS bf16x8*)(lds + MIX_WP + (16 * mi + fr) * 272 + (32 * ks + 8 * fq) * 2);
                    acc[mi][0] = __builtin_amdgcn_mfma_f32_16x16x32_bf16(Bf[0], Af, acc[mi][0], 0, 0, 0); acc[mi][1] = __builtin_amdgcn_mfma_f32_16x16x32_bf16(Bf[1], Af, acc[mi][1], 0, 0, 0); }
                __builtin_amdgcn_sched_barrier(0); }
            const int dl = (256 * t3 + 32 * wave + 8 * fq) * 4;
            const f32x4 g0 = *(const LAS f32x4*)(lds + MIX_LG + dl), g1 = *(const LAS f32x4*)(lds + MIX_LG + dl + 16), b0 = *(const LAS f32x4*)(lds + MIX_LB + dl), b1 = *(const LAS f32x4*)(lds + MIX_LB + dl + 16);
#pragma unroll
            for (int mi = 0; mi < 8; ++mi) { const int i = 16 * mi + fr; const float c1v = c1[i], c2v = c2[i], bsv = *(const LAS float*)(lds + MIX_BSV + i * 4);
                const u32x4 uw = ureg[mi];
                const f32x4 m0 = g0 * (acc[mi][0] - c1v) + b0 * c2v + bsv, m1 = g1 * (acc[mi][1] - c1v) + b1 * c2v + bsv;
                u32x4 w; w.x = cvt_pk_bf16(bf_lo(uw.x) * m0[0], bf_hi(uw.x) * m0[1]); w.y = cvt_pk_bf16(bf_lo(uw.y) * m0[2], bf_hi(uw.y) * m0[3]);
                w.z = cvt_pk_bf16(bf_lo(uw.z) * m1[0], bf_hi(uw.z) * m1[1]); w.w = cvt_pk_bf16(bf_lo(uw.w) * m1[2], bf_hi(uw.w) * m1[3]);
                if (!(PROBE_MASK && dry)) *(u32x4*)(U + blk_off(128 * c + i, d0, DSGU / 64)) = w;
                ureg[mi] = *(const u32x4*)(U + blk_off(128 * nc + i, 768 * nhd + 256 * nt3 + 32 * wave + 8 * fq, DSGU / 64)); }
        }
        if (!ends) { t3 = nt3; newitem = false; continue; }
        if (!nknown) {
            if (tid == 0 && pend_valid) { QW[qp] = G + pend; pend_valid = false; }
            __syncthreads();
            nitem = QW[qp];
            if (nitem < MIX_ITEMS) { mix_decode(nitem, nc, nhd, ntb, nte); nt3 = ntb; MIX_LOAD_V(nc, nhd, nt3); MIX_LOAD_U(ureg, nc, nhd, nt3); }
        }
        more = (nitem < MIX_ITEMS); item = nitem; c = nc; hd = nhd; tb = ntb; te = nte; t3 = nt3; newitem = true; cis = false;
        qp ^= 1; if (tid == 0) QW[qp] = -1;
    }
    __syncthreads();
}
#undef MIX_LOAD_V
#undef MIX_LOAD_U

constexpr int CONV_RUNS = MP / 64, CONV_ITEMS = CONV_RUNS + 2 * (MS / 32);
constexpr int CONV_P = RS_OFF  , CONV_MR = RS_OFF + 1024  ;
__device__ __forceinline__ f32x2 bfx2(unsigned u) { return (f32x2){bf_lo(u), bf_hi(u)}; }
#define CONV_ROW(S) do { if ((S) < 46) { const f32x2 x_ = bfx2(*(const LAS unsigned*)(lds + ((xoff + (S) * 2048) & 0x1FFFF))); \
        _Pragma("unroll") for (int k = 0; k < 31; ++k) { const int o = (S) - k; if (o >= 0 && o < 16) cv[o] = __builtin_elementwise_fma(w[k], x_, cv[o]); } } } while (0)
#define CONV_R2(S) CONV_ROW((S)); CONV_ROW((S) + 1)
#define CONV_R4(S) CONV_R2((S)); CONV_R2((S) + 2)
#define CONV_R8(S) CONV_R4((S)); CONV_R4((S) + 4)
#define CONV_R16(S) CONV_R8((S)); CONV_R8((S) + 8)
template <int N> __device__ __forceinline__ void xred_step(const float (&v)[N], float (&w)[N / 2], int lane) {
    constexpr int H = N / 2; const bool up = (lane & H) != 0;
#pragma unroll
    for (int k = 0; k < H; ++k) { const float send = up ? v[k] : v[k + H], keep = up ? v[k + H] : v[k]; w[k] = keep + SHX(send, H); }
}
__device__ __forceinline__ void conv_half(const f32x2 (&w)[31], f32x2 bias, f32x2 lg, f32x2 lb, LAS unsigned char* lds, bf16_t* out, int xoff, int tid, int wave, int lane) {
    f32x2 cv[16];
#pragma unroll
    for (int o = 0; o < 16; ++o) cv[o] = bias;
    CONV_R16(0); CONV_R16(16); CONV_R8(32); CONV_R4(40); CONV_R2(44);
    float r32[32], r16[16], r8[8], r4[4], r2[2], r1[1];
#pragma unroll
    for (int o = 0; o < 16; ++o) { r32[2 * o] = cv[o].x + cv[o].y; r32[2 * o + 1] = cv[o].x * cv[o].x + cv[o].y * cv[o].y; }
    xred_step<32>(r32, r16, lane); xred_step<16>(r16, r8, lane); xred_step<8>(r8, r4, lane); xred_step<4>(r4, r2, lane); xred_step<2>(r2, r1, lane);
    const float tot = r1[0] + SHX(r1[0], 32);
    LAS float* P = (LAS float*)(lds + CONV_P); LAS f32x2* MR = (LAS f32x2*)(lds + CONV_MR);
    if (lane < 32) P[wave * 32 + lane] = tot;
    __syncthreads();
    if (tid < 16) { float s = 0.f, q = 0.f;
#pragma unroll
        for (int wv = 0; wv < 8; ++wv) { s += P[wv * 32 + 2 * tid]; q += P[wv * 32 + 2 * tid + 1]; }
        const float mean = s * (1.0f / D), var = q * (1.0f / D) - mean * mean; MR[tid] = (f32x2){mean, 1.0f / sqrtf(var + LN_EPS)}; }
    __syncthreads();
#pragma unroll
    for (int o = 0; o < 16; ++o) { const f32x2 mr = MR[o]; const f32x2 y = (cv[o] - mr.x) * mr.y * lg + lb; const f32x2 sg = sigmoid_pk(y);
        *(unsigned*)(out + (size_t)o * D) = cvt_pk_bf16(y.x * sg.x, y.y * sg.y); }
}
__device__ __forceinline__ void conv_stage(const bf16_t* GL, long g0, int r0, int r1, LAS unsigned char* lds, int wave, int lane) {
    for (int r = r0 + wave; r < r1; r += 8) { const char* g = (const char*)(GL + (g0 + r) * D) + lane * 16;
        __builtin_amdgcn_global_load_lds((const unsigned*)g, (LAS unsigned*)(lds + (r & 63) * 2048), 16, 0, 2);
        __builtin_amdgcn_global_load_lds((const unsigned*)(g + 1024), (LAS unsigned*)(lds + (r & 63) * 2048 + 1024), 16, 0, 2); }
}
#define CONV_SYNC() do { asm volatile("s_waitcnt vmcnt(0) lgkmcnt(0)" ::: "memory"); __syncthreads(); } while (0)
__device__ __forceinline__ void conv_phase(int j, LAS unsigned char* lds, int tid, int, int, int c0, int G) {
    unsigned char* ws = KWS();
    const bf16_t* GL = (const bf16_t*)(ws + WS_GLU); bf16_t* CA = (bf16_t*)(ws + WS_CACT);
    const float* wdw = KIN(I_WDW) + (size_t)j * 31 * D; const float* bdw = KIN(I_BDW) + j * D; const float* lng = KIN(I_CLNG) + j * D; const float* lnb = KIN(I_CLNB) + j * D;
    const float* st = KIN(I_STATE) + (size_t)j * 8 * 30 * D;
    unsigned* cctr = (unsigned*)(ws + WS_CTL) + CW_BAR + 96 + 16 * j;
    volatile LAS int* CQ = (volatile LAS int*)(lds + CONV_MR + 128);
    int pendc = CONV_ITEMS - G;
    for (int item = c0; item < CONV_ITEMS; ) {
        asm volatile("" : "+v"(tid));
        const int ch = 2 * tid, lane = tid & 63, wave = __builtin_amdgcn_readfirstlane(tid >> 6);
        const bool smp = (item >= CONV_RUNS); const int hsel = smp ? ((item - CONV_RUNS) & 1) : 0;
        const int t0 = smp ? MP + 32 * ((item - CONV_RUNS) >> 1) : 64 * item; const bool first = !smp && ((t0 & 4095) == 0);
        __syncthreads();
        if (smp) { conv_stage(GL, (long)t0 - 30, 30, 62, lds, wave, lane);
            const float* sp = st + (size_t)((t0 - MP) >> 5) * 30 * D + ch;
#pragma unroll
            for (int s1 = 0; s1 < 30; s1 += 10) { f32x2 sv[10];
#pragma unroll
                for (int s = 0; s < 10; ++s) sv[s] = *(const f32x2*)(sp + (size_t)(s1 + s) * D);
#pragma unroll
                for (int s = 0; s < 10; ++s) *(LAS unsigned*)(lds + (s1 + s) * 2048 + tid * 4) = cvt_pk_bf16(sv[s].x, sv[s].y);
                asm volatile("" ::: "memory"); }
        } else { conv_stage(GL, (long)t0 - 30, first ? 30 : 0, 46, lds, wave, lane);
            if (first) {
#pragma unroll
                for (int s = 0; s < 30; ++s) *(LAS unsigned*)(lds + s * 2048 + tid * 4) = 0u; } }
        f32x2 w[31];
#pragma unroll
        for (int k = 0; k < 31; ++k) w[k] = *(const f32x2*)(wdw + (size_t)k * D + ch);
        const f32x2 bias = *(const f32x2*)(bdw + ch), lg = *(const f32x2*)(lng + ch), lb = *(const f32x2*)(lnb + ch);
        bf16_t* out = CA + (size_t)t0 * D + ch;
        const int nh = smp ? 1 : 4;
#pragma nounroll
        for (int hh = 0; hh < nh; ++hh) { const int h = smp ? hsel : hh;
            CONV_SYNC();
            if (!smp && hh < 3) conv_stage(GL, (long)t0 - 30, 46 + 16 * hh, 62 + 16 * hh, lds, wave, lane);
            if (hh == nh - 1 && tid == 0) pendc = (int)__builtin_amdgcn_atomic_inc32(cctr, 0xFFFFFFFFu, __ATOMIC_RELAXED, "agent");
            conv_half(w, bias, lg, lb, lds, out + (size_t)h * 16 * D, h * 32768 + tid * 4, tid, wave, lane); }
        if (tid == 0) CQ[0] = G + pendc;
        __syncthreads();
        item = CQ[0];
    }
    __syncthreads();
}
#undef CONV_ROW
#undef CONV_R2
#undef CONV_R4
#undef CONV_R8
#undef CONV_R16
#undef CONV_SYNC

enum { K_P0 = 0, K_GIN, K_GLU, K_MIX, K_CONV, K_RES, K_GU, K_FIN };
__host__ __device__ constexpr int phase_kind(int ph) {
    if (ph == 0) return K_P0; if (ph == NPHASE - 1) return K_FIN;
    const int L = (ph - 1) / 5, s = (ph - 1) % 5; const bool sgu = !(L & 1);
    return s == 0 ? (sgu ? K_GIN : K_GLU) : s == 1 ? (sgu ? K_MIX : K_CONV) : s == 3 ? K_GU : K_RES;
}
template <int PH>
__device__ __forceinline__ void run_phase(LAS unsigned char* lds, LAS float* rstab, int tid, int G, int bx) {
    asm volatile("" : "+v"(tid), "+s"(G), "+s"(bx));
    const int lane = tid & 63, wave = __builtin_amdgcn_readfirstlane(tid >> 6), gw = bx * 8 + wave, NGW = G * 8;
    constexpr int kind = phase_kind(PH);
    constexpr int L = (PH - 1) / 5, s = (PH - 1) % 5, j = L >> 1; constexpr bool sgu = !(L & 1);
    constexpr int reps = (PROBE_MASK && ((PROBE_MASK >> kind) & 1)) ? 2 : 1;
#pragma unroll 1
    for (int rep = 0; rep < reps; ++rep) {
        const bool dry = (rep + 1 < reps); (void)dry;
        if (PROBE_MASK && rep) { __syncthreads(); asm volatile("" : "+v"(tid), "+s"(G), "+s"(bx)); }
        pg8::StaticOrder S;
        if constexpr (kind == K_P0) {
            convert_layer(0, lds, gw, NGW, wave, lane);
            p0_rows(gw, NGW, lane);
        } else if constexpr (kind == K_FIN) {
            final_rows(gw, NGW, lane, dry);
        } else if constexpr (kind == K_GIN) {
            unsigned char* ws = KWS();
            for (int tr = 0; tr < (((PROBE_MASK >> 10) & 1) + 1); ++tr) {
                if (G == 256) thin::t_in3(bx, tid, wave, lane, lds, (const bf16_t*)(ws + WS_XB), (const bf16_t*)(ws + WS_SLOTA + SA_WIN), KIN(I_BIN) + j * DSF, (const float*)(ws + WS_SSQSA), (bf16_t*)(ws + WS_U), (bf16_t*)(ws + WS_V), (float*)(ws + WS_VSTAT), KOUT() + O_SV + (size_t)j * MS * DSGU);
                else for (int t = bx; t < 768; t += G) thin::t_in(t, tid, wave, lane, lds, (const bf16_t*)(ws + WS_XB), (const bf16_t*)(ws + WS_SLOTA + SA_WIN), KIN(I_BIN) + j * DSF, (const float*)(ws + WS_SSQSA), (bf16_t*)(ws + WS_U), (bf16_t*)(ws + WS_V), (float*)(ws + WS_VSTAT), KOUT() + O_SV + (size_t)j * MS * DSGU); }
            __syncthreads();
            pg8::Gemm g{(const bf16_t*)(ws + WS_XB), (const bf16_t*)(ws + WS_SLOTA + SA_WIN), MP, DSF, D}; S.init(MP, DSF, G, bx);
            pg8::EpiIn E{(bf16_t*)(ws + WS_U), (bf16_t*)(ws + WS_V), (float*)(ws + WS_VSTAT), KIN(I_BIN) + j * DSF, (const float*)(ws + WS_SSQA)};
            pg8::gemm_phase<pg8::EpiIn, true, true>(lds, rstab, g, S, E, tid);
        } else if constexpr (kind == K_GLU) {
            unsigned char* ws = KWS(); float* out = KOUT();
            for (int tr = 0; tr < (((PROBE_MASK >> 10) & 1) + 1); ++tr) { for (int t = bx; t < 256; t += G) thin::t_glu(thin::xcd_unit(t, G, 1), tid, wave, lane, lds, (const bf16_t*)(ws + WS_XB), (const bf16_t*)(ws + WS_SLOTB + SB_PW1), KIN(I_BPW1) + j * 2 * D, (const float*)(ws + WS_SSQSA), (bf16_t*)(ws + WS_GLU), out + O_CS + (size_t)j * 8 * 30 * D); }
            __syncthreads();
            pg8::Gemm g{(const bf16_t*)(ws + WS_XB), (const bf16_t*)(ws + WS_SLOTB + SB_PW1), MP, 2 * D, D}; S.init(MP, 2 * D, G, bx);
            pg8::EpiGLU E{(bf16_t*)(ws + WS_GLU), (const float*)(ws + WS_SSQA), KIN(I_BPW1) + j * 2 * D, out + O_CP + (size_t)j * 4 * 30 * D};
            pg8::gemm_phase<pg8::EpiGLU, true, true>(lds, rstab, g, S, E, tid);
        } else if constexpr (kind == K_MIX) {
            sample_v_rows(j, gw, NGW, lane, dry);
            mix_phase(j, lds, tid, wave, lane, bx, G, dry);
        } else if constexpr (kind == K_CONV) {
            conv_phase(j, lds, tid, wave, lane, bx, G);
        } else if constexpr (kind == K_GU) {
            unsigned char* ws = KWS();
            const bf16_t* W = (const bf16_t*)(ws + (sgu ? WS_SLOTA + SA_WGU : WS_SLOTB + SB_WGU));
            if constexpr (L <= 2) { constexpr int NFULL = (M / 256 * (NGU / 256)) % 256;
                if (bx >= NFULL) convert_layer(L + 1, lds, (bx - NFULL) * 8 + wave, (G - NFULL) * 8, wave, lane); }
            pg8::Gemm g{(const bf16_t*)(ws + WS_XB), W, M, NGU, D}; S.init(M, NGU, G, bx);
            pg8::EpiGU E{(bf16_t*)(ws + WS_HID), (const float*)(ws + WS_SSQB), (const float*)(ws + WS_SSQSB)};
            pg8::gemm_phase<pg8::EpiGU, true, true>(lds, rstab, g, S, E, tid);
        } else {
            unsigned char* ws = KWS();
            constexpr int K = (s == 2) ? (sgu ? DSGU : D) : DFF;
            constexpr bool ABLK_A = !(s == 2 && !sgu);
            const bf16_t* A = (const bf16_t*)(ws + ((s == 2) ? (sgu ? WS_U : WS_CACT) : WS_HID));
            const bf16_t* W = (const bf16_t*)(ws + ((s == 2) ? (sgu ? WS_SLOTA + SA_WOUT : WS_SLOTB + SB_PW2) : (sgu ? WS_SLOTA + SA_WDN : WS_SLOTB + SB_WDN)));
            const float* bias = (s == 2) ? (sgu ? KIN(I_BOUT) + j * D : KIN(I_BPW2) + j * D) : nullptr;
            float* ssqo = (float*)(ws + ((s == 2) ? WS_SSQB : WS_SSQA)); float* ssqso = (float*)(ws + ((s == 2) ? WS_SSQSB : WS_SSQSA));
            const float* bp = nullptr; const float* bsp = nullptr;
            if constexpr (L == 0 && s == 2) { bp = KIN(I_XP); bsp = KIN(I_XS); }
            for (int tr = 0; tr < (((PROBE_MASK >> 10) & 1) + 1); ++tr) { for (int t = bx; t < 256; t += G) thin::t_res(thin::xcd_unit(t, G, 1), tid, wave, lane, lds, A, K, W, bias, bsp, (bf16_t*)(ws + WS_XB), ssqso, dry || (PROBE_MASK && tr == 0 && ((PROBE_MASK >> 10) & 1)), ABLK_A); }
            __syncthreads();
            pg8::Gemm g{A, W, MP, D, K};
            pg8::EpiRes E{bp, (bf16_t*)(ws + WS_XB), ssqo, bias, dry};
            S.init(MP, D, G, bx);
            pg8::gemm_phase<pg8::EpiRes, true, true, ABLK_A>(lds, rstab, g, S, E, tid);
        }
    }
}

__global__ void __launch_bounds__(512, 2) trunk_fwd(Args args) {
    extern __shared__ __attribute__((aligned(16))) unsigned char lds_raw[];
    LAS unsigned char* lds = (LAS unsigned char*)lds_raw;
    const int tid0 = threadIdx.x;
    const int G0 = gridDim.x, bx0 = blockIdx.x;
    volatile LAS unsigned* MISC = (volatile LAS unsigned*)(lds + MISC_OFF);
    LAS float* rstab = (LAS float*)(lds + RS_OFF);
    for (int u = tid0; u < (LDS_BYTES - LDSCTL_OFF) / 4; u += 512) ((LAS unsigned*)(lds + LDSCTL_OFF))[u] = 0u;
    __syncthreads();
    const int ph_lo = args.ph_lo, ph_hi = args.ph_hi;
    XcdBarrier bar; bar.bar = nullptr; bar.x = 0; bar.st = nullptr;
    if (ph_hi - ph_lo > 1) bar = xcd_barrier_post((unsigned*)(KWS() + WS_CTL) + CW_BAR, MISC + 8);
    unsigned long long dsum = 0ull;
#define PHASE(k) if (ph_lo <= (k) && (k) < ph_hi) { const unsigned long long t0_ = (PROBE_T >> (k)) & 1u ? __builtin_amdgcn_s_memrealtime() : 0ull; run_phase<k>(lds, rstab, tid0, G0, bx0); \
        if (((PROBE_T >> (k)) & 1u) && (PROBE_T >> 31)) dsum += __builtin_amdgcn_s_memrealtime() - t0_; \
        if ((k) + 1 < ph_hi) { bar.bar = (unsigned*)(KWS() + WS_CTL) + CW_BAR; xcd_barrier(bar); if ((PROBE_MASK >> 9) & 1) xcd_barrier(bar); } \
        if (((PROBE_T >> (k)) & 1u) && !(PROBE_T >> 31)) dsum += __builtin_amdgcn_s_memrealtime() - t0_; }
    PHASE(0) PHASE(1) PHASE(2) PHASE(3) PHASE(4) PHASE(5) PHASE(6) PHASE(7) PHASE(8) PHASE(9) PHASE(10)
    PHASE(11) PHASE(12) PHASE(13) PHASE(14) PHASE(15) PHASE(16) PHASE(17) PHASE(18) PHASE(19) PHASE(20) PHASE(21)
#undef PHASE
    if (PROBE_T && bx0 == 0 && tid0 == 0) { const unsigned long long t = __builtin_amdgcn_s_memrealtime(); while (__builtin_amdgcn_s_memrealtime() - t < 8ull * dsum) __builtin_amdgcn_s_sleep(16); }
}

extern "C" void kernel_launch(void* const* d_in, const int* in_sizes, int n_in, void* d_out, int out_size, void* d_ws, size_t ws_size, hipStream_t stream) {
    static int grid = 0;
    constexpr int NL = MK_N_LAUNCHES;
    if (grid == 0) {
        if (n_in != 25 || in_sizes[0] != MP * D || (size_t)out_size != O_END || ws_size < WS_END) {
            fprintf(stderr, "kernel_launch: unexpected shapes: n_in %d in0 %d out %d ws %zu (need %zu)\n", n_in, n_in > 0 ? in_sizes[0] : -1, out_size, ws_size, (size_t)WS_END); grid = -1; return; }
        int dev = 0, cus = 0, per_cu = 0;
        if (hipGetDevice(&dev) != hipSuccess || hipDeviceGetAttribute(&cus, hipDeviceAttributeMultiprocessorCount, dev) != hipSuccess) { grid = -1; return; }
        if (hipFuncSetAttribute((const void*)trunk_fwd, hipFuncAttributeMaxDynamicSharedMemorySize, LDS_BYTES) != hipSuccess) { fprintf(stderr, "kernel_launch: hipFuncSetAttribute failed\n"); grid = -1; return; }
        if (hipOccupancyMaxActiveBlocksPerMultiprocessor(&per_cu, (const void*)trunk_fwd, 512, LDS_BYTES) != hipSuccess || per_cu < 1) fprintf(stderr, "kernel_launch: occupancy query reports %d workgroups per CU\n", per_cu);
        (void)hipGetLastError();
        grid = cus;
    }
    if (grid < 0) return;
    if (hipMemsetAsync((char*)d_ws + WS_CTL + (size_t)CW_BAR * 4, 0, (size_t)XCD_BAR_WORDS * 4, stream) != hipSuccess)     { fprintf(stderr, "kernel_launch: memset failed\n"); return; }
    Args a{};
    for (int i = 0; i < 25; ++i) a.in[i] = (const float*)d_in[i];
    a.out = (float*)d_out; a.ws = (unsigned char*)d_ws;
    if (NL == 1) { a.ph_lo = 0; a.ph_hi = NPHASE; hipLaunchKernelGGL(trunk_fwd, dim3(grid), dim3(512), LDS_BYTES, stream, a); }
    else for (int ph = 0; ph < NPHASE; ++ph) { a.ph_lo = ph; a.ph_hi = ph + 1; hipLaunchKernelGGL(trunk_fwd, dim3(grid), dim3(512), LDS_BYTES, stream, a); }
    const hipError_t le = hipPeekAtLastError();
    if (le != hipSuccess) fprintf(stderr, "kernel_launch: launch failed: %s\n", hipGetErrorName(le));
}
```
